# Optimizing an MI355X kernel written in HIP

```python
import math
import jax, jax.numpy as jnp
from jax import lax
import numpy as np

D_MODEL = 1024
BATCH = 1
SEQ = 16384
DEPTH = 2

HEAD_DIM = 64
MOBA_HEADS = 4
MOBA_BLOCK = 256
MOBA_TOPK = 3
SWA_Q_HEADS = 4
SWA_KV_HEADS = 2
SWA_WINDOW = 128
DIFF_HEADS = 4
DIFF_V_DIM = 2 * HEAD_DIM
A_Q = MOBA_HEADS * HEAD_DIM
B_Q = SWA_Q_HEADS * HEAD_DIM
B_KV = SWA_KV_HEADS * HEAD_DIM
C_QK = DIFF_HEADS * 2 * HEAD_DIM
C_V = DIFF_HEADS * DIFF_V_DIM
N_BRANCH = 3
SPLIT_SIZES = (A_Q, A_Q, A_Q, B_Q, B_KV, B_KV, C_QK, C_QK, C_V, N_BRANCH * D_MODEL)
IN_COLS = A_Q * 3 + B_Q + 2 * B_KV + 2 * C_QK + C_V + N_BRANCH * D_MODEL
D_FF = 2816
FFN_HALF = 0.5
ROPE_THETA = 10000.0
Q_BLOCK = 128
EPS = 1e-6
NEG = -1e30

kernel_name = "hybrid_moba_swa_diff_macaron"


def rmsnorm(x, gain):
    xf = x.astype(jnp.float32)
    y = xf * lax.rsqrt(jnp.mean(xf * xf, axis=-1, keepdims=True) + EPS)
    return (y * gain.astype(jnp.float32)).astype(x.dtype)


def rope_tables(seq):
    pos = jnp.arange(seq, dtype=jnp.float32)
    inv_freq = ROPE_THETA ** (-jnp.arange(0, HEAD_DIM, 2, dtype=jnp.float32) / HEAD_DIM)
    ang = pos[:, None] * inv_freq[None, :]
    return jnp.cos(ang), jnp.sin(ang)


def apply_rope(x, cos, sin):
    xf = x.astype(jnp.float32)
    x1, x2 = jnp.split(xf, 2, axis=-1)
    out = jnp.concatenate([x1 * cos - x2 * sin, x2 * cos + x1 * sin], axis=-1)
    return out.astype(x.dtype)


def to_heads(t, n_heads, dim):
    b, s, _ = t.shape
    return t.reshape(b, s, n_heads, dim).transpose(0, 2, 1, 3)


def from_heads(t):
    b, h, s, d = t.shape
    return t.transpose(0, 2, 1, 3).reshape(b, s, h * d)


def qk_prep(t, gain, cos, sin):
    return apply_rope(rmsnorm(t, gain), cos, sin)


def swiglu(x, w_gate, w_up, w_down):
    return (jax.nn.silu(x @ w_gate) * (x @ w_up)) @ w_down


def moba_attention(q, k, v):
    b, h, s, dh = q.shape
    nb = -(-s // MOBA_BLOCK)
    pad = nb * MOBA_BLOCK - s
    kp = jnp.pad(k, ((0, 0), (0, 0), (0, pad), (0, 0)))
    vp = jnp.pad(v, ((0, 0), (0, 0), (0, pad), (0, 0)))
    kb = kp.reshape(b, h, nb, MOBA_BLOCK, dh)
    vb = vp.reshape(b, h, nb, MOBA_BLOCK, dh)
    kmean = jnp.mean(kb.astype(jnp.float32), axis=3)
    n_sel = min(MOBA_TOPK, nb - 1)
    scale = dh ** -0.5
    bi = jnp.arange(b)[:, None, None, None]
    hi = jnp.arange(h)[None, :, None, None]
    n_chunks = s // Q_BLOCK

    def chunk(c):
        start = c * Q_BLOCK
        qc = lax.dynamic_slice_in_dim(q, start, Q_BLOCK, axis=2)
        tq = start + jnp.arange(Q_BLOCK)
        cur = start // MOBA_BLOCK
        own_k = lax.dynamic_index_in_dim(kb, cur, axis=2, keepdims=False)
        own_v = lax.dynamic_index_in_dim(vb, cur, axis=2, keepdims=False)
        kpos = cur * MOBA_BLOCK + jnp.arange(MOBA_BLOCK)
        s_own = jnp.einsum('bhqd,bhkd->bhqk', qc, own_k, preferred_element_type=jnp.float32) * scale
        s_own = jnp.where(kpos[None, :] <= tq[:, None], s_own, NEG)
        if n_sel > 0:
            gate = jnp.einsum('bhqd,bhnd->bhqn', qc.astype(jnp.float32), kmean)
            past = jnp.arange(nb) < cur
            gate = jnp.where(past, gate, NEG)
            _, gidx = lax.top_k(gate, n_sel)
            valid = past[gidx]
            kg = kb[bi, hi, gidx]
            vg = vb[bi, hi, gidx]
            s_sel = jnp.einsum('bhqd,bhqnkd->bhqnk', qc, kg, preferred_element_type=jnp.float32) * scale
            s_sel = jnp.where(valid[..., None], s_sel, NEG)
            n_keys = n_sel * MOBA_BLOCK
            s_all = jnp.concatenate([s_sel.reshape(b, h, Q_BLOCK, n_keys), s_own], axis=-1)
            p = jax.nn.softmax(s_all, axis=-1).astype(v.dtype)
            p_sel = p[..., :n_keys].reshape(b, h, Q_BLOCK, n_sel, MOBA_BLOCK)
            p_own = p[..., n_keys:]
            return (jnp.einsum('bhqnk,bhqnkd->bhqd', p_sel, vg)
                    + jnp.einsum('bhqk,bhkd->bhqd', p_own, own_v))
        p_own = jax.nn.softmax(s_own, axis=-1).astype(v.dtype)
        return jnp.einsum('bhqk,bhkd->bhqd', p_own, own_v)

    outs = lax.map(chunk, jnp.arange(n_chunks))
    return outs.transpose(1, 2, 0, 3, 4).reshape(b, h, s, dh)


def sliding_window_sink_attention(q, k, v, sinks):
    b, hq, s, dh = q.shape
    hkv = k.shape[1]
    g = hq // hkv
    nc = s // Q_BLOCK
    scale = dh ** -0.5
    qb = q.reshape(b, hkv, g, nc, Q_BLOCK, dh)
    kb = k.reshape(b, hkv, nc, Q_BLOCK, dh)
    vb = v.reshape(b, hkv, nc, Q_BLOCK, dh)
    pad = ((0, 0), (0, 0), (1, 0), (0, 0), (0, 0))
    kband = jnp.concatenate([jnp.pad(kb, pad)[:, :, :-1], kb], axis=3)
    vband = jnp.concatenate([jnp.pad(vb, pad)[:, :, :-1], vb], axis=3)
    sc = jnp.einsum('bhgcqd,bhckd->bhgcqk', qb, kband, preferred_element_type=jnp.float32) * scale
    diff = (jnp.arange(Q_BLOCK)[:, None] + Q_BLOCK) - jnp.arange(2 * Q_BLOCK)[None, :]
    in_window = (diff >= 0) & (diff < SWA_WINDOW)
    kabs = (jnp.arange(nc)[:, None] - 1) * Q_BLOCK + jnp.arange(2 * Q_BLOCK)[None, :]
    mask = in_window[None] & (kabs >= 0)[:, None, :]
    sc = jnp.where(mask, sc, NEG)
    sink = sinks.astype(jnp.float32).reshape(hkv, g)[None, :, :, None, None, None]
    sink = jnp.broadcast_to(sink, sc.shape[:-1] + (1,))
    p = jax.nn.softmax(jnp.concatenate([sc, sink], axis=-1), axis=-1)[..., :-1]
    out = jnp.einsum('bhgcqk,bhckd->bhgcqd', p.astype(v.dtype), vband)
    return out.reshape(b, hq, s, dh)


def differential_attention(q1, q2, k1, k2, v, lam):
    b, h, s, dh = q1.shape
    nc = s // Q_BLOCK
    scale = dh ** -0.5
    kpos = jnp.arange(s)

    def chunk(c):
        start = c * Q_BLOCK
        causal = kpos[None, :] <= (start + jnp.arange(Q_BLOCK))[:, None]

        def attn_map(qq, kk):
            qc = lax.dynamic_slice_in_dim(qq, start, Q_BLOCK, axis=2)
            sc = jnp.einsum('bhqd,bhkd->bhqk', qc, kk, preferred_element_type=jnp.float32) * scale
            return jax.nn.softmax(jnp.where(causal, sc, NEG), axis=-1)

        a = attn_map(q1, k1) - lam * attn_map(q2, k2)
        return jnp.einsum('bhqk,bhkd->bhqd', a.astype(v.dtype), v)

    outs = lax.map(chunk, jnp.arange(nc))
    return outs.transpose(1, 2, 0, 3, 4).reshape(b, h, s, v.shape[-1])


def token_mixing(h, cos, sin, lam_init, w_in, moba_q_norm, moba_k_norm, swa_q_norm,
                 swa_k_norm, swa_sinks, diff_q_norm, diff_k_norm, lq1, lk1, lq2, lk2,
                 diff_subln, w_branch_a, w_branch_b, w_branch_c, w_out):
    b, s, _ = h.shape
    points = np.cumsum(SPLIT_SIZES)[:-1].tolist()
    proj = h @ w_in
    qa, ka, va, qb, kb, vb, qc, kc, vc, gate_logits = jnp.split(proj, points, axis=-1)
    qa = qk_prep(to_heads(qa, MOBA_HEADS, HEAD_DIM), moba_q_norm, cos, sin)
    ka = qk_prep(to_heads(ka, MOBA_HEADS, HEAD_DIM), moba_k_norm, cos, sin)
    va = to_heads(va, MOBA_HEADS, HEAD_DIM)
    ya = from_heads(moba_attention(qa, ka, va)) @ w_branch_a
    qb = qk_prep(to_heads(qb, SWA_Q_HEADS, HEAD_DIM), swa_q_norm, cos, sin)
    kb = qk_prep(to_heads(kb, SWA_KV_HEADS, HEAD_DIM), swa_k_norm, cos, sin)
    vb = to_heads(vb, SWA_KV_HEADS, HEAD_DIM)
    yb = from_heads(sliding_window_sink_attention(qb, kb, vb, swa_sinks)) @ w_branch_b
    q1, q2 = jnp.split(to_heads(qc, DIFF_HEADS, 2 * HEAD_DIM), 2, axis=-1)
    k1, k2 = jnp.split(to_heads(kc, DIFF_HEADS, 2 * HEAD_DIM), 2, axis=-1)
    q1 = qk_prep(q1, diff_q_norm, cos, sin)
    q2 = qk_prep(q2, diff_q_norm, cos, sin)
    k1 = qk_prep(k1, diff_k_norm, cos, sin)
    k2 = qk_prep(k2, diff_k_norm, cos, sin)
    vc = to_heads(vc, DIFF_HEADS, DIFF_V_DIM)
    f32 = jnp.float32
    lam = (jnp.exp(jnp.sum(lq1.astype(f32) * lk1.astype(f32)))
           - jnp.exp(jnp.sum(lq2.astype(f32) * lk2.astype(f32))) + lam_init)
    oc = differential_attention(q1, q2, k1, k2, vc, lam)
    oc = rmsnorm(oc, diff_subln) * (1.0 - lam_init)
    yc = from_heads(oc) @ w_branch_c
    gates = jax.nn.sigmoid(gate_logits.astype(f32)).astype(h.dtype).reshape(b, s, N_BRANCH, D_MODEL)
    merged = gates[:, :, 0] * ya + gates[:, :, 1] * yb + gates[:, :, 2] * yc
    return merged @ w_out


def setup_inputs(seed: int = 0) -> dict:
    key = jax.random.key(seed)
    ks = jax.random.split(key, 32)
    L, D, F, dh = DEPTH, D_MODEL, D_FF, HEAD_DIM

    def w(k, shape, fan_in):
        return jax.random.normal(k, shape, jnp.float32) * fan_in ** -0.5

    def gain(k, shape):
        return 1.0 + 0.02 * jax.random.normal(k, shape, jnp.float32)

    def small(k, shape, sc):
        return sc * jax.random.normal(k, shape, jnp.float32)

    return {
        "x": jax.random.normal(ks[0], (BATCH, SEQ, D), jnp.float32),
        "ffn1_norm": gain(ks[1], (L, D)),
        "ffn1_w_gate": w(ks[2], (L, D, F), D),
        "ffn1_w_up": w(ks[3], (L, D, F), D),
        "ffn1_w_down": w(ks[4], (L, F, D), F),
        "mix_norm": gain(ks[5], (L, D)),
        "w_in": w(ks[6], (L, D, IN_COLS), D),
        "moba_q_norm": gain(ks[7], (L, dh)),
        "moba_k_norm": gain(ks[8], (L, dh)),
        "swa_q_norm": gain(ks[9], (L, dh)),
        "swa_k_norm": gain(ks[10], (L, dh)),
        "swa_sinks": small(ks[11], (L, SWA_Q_HEADS), 0.5),
        "diff_q_norm": gain(ks[12], (L, dh)),
        "diff_k_norm": gain(ks[13], (L, dh)),
        "diff_lambda_q1": small(ks[14], (L, dh), 0.1),
        "diff_lambda_k1": small(ks[15], (L, dh), 0.1),
        "diff_lambda_q2": small(ks[16], (L, dh), 0.1),
        "diff_lambda_k2": small(ks[17], (L, dh), 0.1),
        "diff_subln": gain(ks[18], (L, DIFF_V_DIM)),
        "w_branch_a": w(ks[19], (L, A_Q, D), A_Q),
        "w_branch_b": w(ks[20], (L, B_Q, D), B_Q),
        "w_branch_c": w(ks[21], (L, C_V, D), C_V),
        "w_out": w(ks[22], (L, D, D), D),
        "ffn2_norm": gain(ks[23], (L, D)),
        "ffn2_w_gate": w(ks[24], (L, D, F), D),
        "ffn2_w_up": w(ks[25], (L, D, F), D),
        "ffn2_w_down": w(ks[26], (L, F, D), F),
    }


def reference(x, ffn1_norm, ffn1_w_gate, ffn1_w_up, ffn1_w_down, mix_norm, w_in,
              moba_q_norm, moba_k_norm, swa_q_norm, swa_k_norm, swa_sinks,
              diff_q_norm, diff_k_norm, diff_lambda_q1, diff_lambda_k1,
              diff_lambda_q2, diff_lambda_k2, diff_subln, w_branch_a, w_branch_b,
              w_branch_c, w_out, ffn2_norm, ffn2_w_gate, ffn2_w_up, ffn2_w_down):
    cos, sin = rope_tables(x.shape[1])
    for l in range(DEPTH):
        lam_init = 0.8 - 0.6 * math.exp(-0.3 * l)
        x = x + FFN_HALF * swiglu(rmsnorm(x, ffn1_norm[l]), ffn1_w_gate[l], ffn1_w_up[l], ffn1_w_down[l])
        x = x + token_mixing(rmsnorm(x, mix_norm[l]), cos, sin, lam_init, w_in[l],
                             moba_q_norm[l], moba_k_norm[l], swa_q_norm[l], swa_k_norm[l],
                             swa_sinks[l], diff_q_norm[l], diff_k_norm[l],
                             diff_lambda_q1[l], diff_lambda_k1[l], diff_lambda_q2[l],
                             diff_lambda_k2[l], diff_subln[l], w_branch_a[l], w_branch_b[l],
                             w_branch_c[l], w_out[l])
        x = x + FFN_HALF * swiglu(rmsnorm(x, ffn2_norm[l]), ffn2_w_gate[l], ffn2_w_up[l], ffn2_w_down[l])
    return x
```

```cpp
#include <hip/hip_runtime.h>
#include <cstdio>
#include <cstdint>
#include <hip/hip_cooperative_groups.h>
namespace pg8 {
#define PG8_LAS __attribute__((address_space(3)))
typedef unsigned short bf16_t;
typedef short bf16x8 __attribute__((ext_vector_type(8)));
typedef float f32x4 __attribute__((ext_vector_type(4)));
typedef unsigned u32x4 __attribute__((ext_vector_type(4)));
constexpr int BM = 256, BK = 64, HALF = 128, HTB = HALF * BK * 2  , STAGE_BYTES = 8 * HTB, NXCD = 8, WGM = 8;

__host__ __device__ __forceinline__ int lds_byte(int r, int c) { const int st = (r >> 4) * 2 + (c >> 5), rr = r & 15, cc = c & 31, ob = rr * 64 + cc * 2; return st * 1024 + (ob ^ (((ob >> 9) & 1) << 5)); }
__host__ __device__ __forceinline__ void stage_rc(int b, int& R, int& C) { const int st = b / 1024, sb = b % 1024, swz = sb ^ (((sb >> 9) & 1) << 5); R = (st >> 1) * 16 + swz / 64; C = (st & 1) * 32 + (swz % 64) / 2; }
__host__ __device__ __forceinline__ int perm32(int rho) { const int n = rho >> 4, i = rho & 15; return 8 * (i >> 2) + 4 * n + (i & 3); }

struct Unit { int pm, pn; };
struct Gemm { const bf16_t* A; const bf16_t* Bt; int M, N, K, lda; };

struct StaticOrder {
    int nM, nN, nwg, G, c;
    __host__ __device__ void init(int M, int N, int G_, int c_) { nM = M / BM; nN = N / BM; nwg = nM * nN; G = G_; c = c_; }
    __host__ __device__ bool next(int i, Unit& u) const {
        const long L = (long)i * G + c; if (L >= nwg) return false;
        int wgid = (int)L; { const int q = nwg / NXCD, r = nwg % NXCD, xcd = wgid % NXCD, off = wgid / NXCD; wgid = (xcd < r ? xcd * (q + 1) : r * (q + 1) + (xcd - r) * q) + off; }
        const int nig = WGM * nN, gid = wgid / nig, fm = gid * WGM, gsz = (nM - fm) < WGM ? (nM - fm) : WGM;
        u.pm = fm + ((wgid % nig) % gsz); u.pn = (wgid % nig) / gsz; return true;
    }
    __device__ __forceinline__ void a_ready(const Unit&) const {}
    __device__ __forceinline__ void done(const Unit&) const {}
};

typedef float f32x2_t __attribute__((ext_vector_type(2))); typedef __bf16 bf16x2_t __attribute__((ext_vector_type(2)));
__device__ __forceinline__ unsigned cvt_pk_bf16(float lo, float hi) { f32x2_t v = {lo, hi}; bf16x2_t b = __builtin_convertvector(v, bf16x2_t); return __builtin_bit_cast(unsigned, b); }
__device__ __forceinline__ u32x4 pack8(const f32x4 a, const f32x4 b) { u32x4 w; w.x = cvt_pk_bf16(a[0], a[1]); w.y = cvt_pk_bf16(a[2], a[3]); w.z = cvt_pk_bf16(b[0], b[1]); w.w = cvt_pk_bf16(b[2], b[3]); return w; }
__device__ __forceinline__ void unpack8(const u32x4 w, f32x4& a, f32x4& b) {
    a[0] = __uint_as_float(w.x << 16); a[1] = __uint_as_float(w.x & 0xffff0000u); a[2] = __uint_as_float(w.y << 16); a[3] = __uint_as_float(w.y & 0xffff0000u);
    b[0] = __uint_as_float(w.z << 16); b[1] = __uint_as_float(w.z & 0xffff0000u); b[2] = __uint_as_float(w.w << 16); b[3] = __uint_as_float(w.w & 0xffff0000u); }
__device__ __forceinline__ float rstd_of(const float* ssq, int row) { const f32x4 a = *(const f32x4*)(ssq + (size_t)row * 4);
    return __builtin_amdgcn_rsqf(((a[0] + a[1]) + (a[2] + a[3])) * (1.0f / 1024.0f) + 1e-6f); }
__device__ __forceinline__ float sigm(float g) { return __builtin_amdgcn_rcpf(1.0f + __builtin_amdgcn_exp2f(-1.4426950408889634f * g)); }

struct EpiFFNUp {
    static constexpr bool PERM = false, AFTER_DRAIN = false;
    bf16_t* O; const float* ssq;
    __device__ __forceinline__ void operator()(const f32x4 (&acc)[2][2][4][2], const Unit& u, int wr, int wc, int fr, int fq) const {
        const int row0 = u.pm * BM + wr * 64 + fr, col0 = u.pn * 128 + wc * 32 + 8 * fq;
#pragma unroll
        for (int ai = 0; ai < 2; ++ai)
#pragma unroll
            for (int m = 0; m < 4; ++m) { if (m == 0) asm volatile("" ::: "memory"); const int row = row0 + ai * HALF + m * 16; const float rs = rstd_of(ssq, row);
                f32x4 o[2];
#pragma unroll
                for (int n = 0; n < 2; ++n) { const f32x4 g = acc[ai][0][m][n] * rs, up = acc[ai][1][m][n] * rs;
#pragma unroll
                    for (int e = 0; e < 4; ++e) o[n][e] = g[e] * sigm(g[e]) * up[e]; }
                *(u32x4*)(O + (size_t)row * 2816 + col0) = pack8(o[0], o[1]); }
    }
};
struct EpiResid {
    static constexpr bool PERM = false, AFTER_DRAIN = true;
    const float* Xin; float* X; bf16_t* XB; float* ssq_out; float scale;
    __device__ __forceinline__ void fused(const f32x4 (&acc)[2][2][4][2], const Unit& u, int wr, int wc, int fr, int fq, PG8_LAS unsigned char* lds, int wid, int lane) const {
        PG8_LAS float* P = (PG8_LAS float*)lds;
        const int row0 = u.pm * BM + wr * 64 + fr, col0 = u.pn * BM + wc * 32 + 8 * fq;
#pragma unroll
        for (int ai = 0; ai < 2; ++ai)
#pragma unroll
            for (int m = 0; m < 4; ++m) { if ((m & 1) == 0) asm volatile("" ::: "memory"); const int row = row0 + ai * HALF + m * 16; float ss = 0.f;
#pragma unroll
                for (int bj = 0; bj < 2; ++bj) { float* p = X + (size_t)row * 1024 + col0 + bj * HALF; const float* pi = Xin + (size_t)row * 1024 + col0 + bj * HALF;
                    f32x4 x0 = *(const f32x4*)pi, x1 = *(const f32x4*)(pi + 4);
                    x0 = x0 + acc[ai][bj][m][0] * scale; x1 = x1 + acc[ai][bj][m][1] * scale;
                    *(f32x4*)p = x0; *(f32x4*)(p + 4) = x1;
                    ss += (x0[0] * x0[0] + x0[1] * x0[1]) + (x0[2] * x0[2] + x0[3] * x0[3]) + (x1[0] * x1[0] + x1[1] * x1[1]) + (x1[2] * x1[2] + x1[3] * x1[3]);
                    *(u32x4*)(XB + (size_t)row * 1024 + col0 + bj * HALF) = pack8(x0, x1); }
                ss += __shfl_xor(ss, 16); ss += __shfl_xor(ss, 32);
                if (fq == 0) P[(ai * HALF + wr * 64 + m * 16 + fr) * 4 + wc] = ss; }
        asm volatile("s_waitcnt lgkmcnt(0)" ::: "memory"); __builtin_amdgcn_s_barrier(); asm volatile("" ::: "memory");
        { const int r = wid * 32 + (lane & 31);
          if (lane < 32) { const f32x4 q = *(const PG8_LAS f32x4*)(P + r * 4); ssq_out[(size_t)(u.pm * BM + r) * 4 + u.pn] = (q[0] + q[1]) + (q[2] + q[3]); } }
        asm volatile("s_waitcnt lgkmcnt(0)" ::: "memory"); __builtin_amdgcn_s_barrier(); asm volatile("" ::: "memory");
    }
};
struct EpiGate {
    static constexpr bool PERM = false, AFTER_DRAIN = false;
    bf16_t* O; const float* ssq;
    __device__ __forceinline__ void operator()(const f32x4 (&acc)[2][2][4][2], const Unit& u, int wr, int wc, int fr, int fq) const {
        const int row0 = u.pm * BM + wr * 64 + fr, col0 = u.pn * BM + wc * 32 + 8 * fq;
#pragma unroll
        for (int ai = 0; ai < 2; ++ai)
#pragma unroll
            for (int m = 0; m < 4; ++m) { if (m == 0) asm volatile("" ::: "memory"); const int row = row0 + ai * HALF + m * 16; const float rs = rstd_of(ssq, row);
#pragma unroll
                for (int bj = 0; bj < 2; ++bj) { f32x4 o[2];
#pragma unroll
                    for (int n = 0; n < 2; ++n)
#pragma unroll
                        for (int e = 0; e < 4; ++e) o[n][e] = sigm(acc[ai][bj][m][n][e] * rs);
                    *(u32x4*)(O + (size_t)row * 1024 + col0 + bj * HALF) = pack8(o[0], o[1]); } }
    }
    __device__ __forceinline__ void fused(const f32x4 (&acc)[2][2][4][2], const Unit& u, int wr, int wc, int fr, int fq, PG8_LAS unsigned char*, int, int) const { (*this)(acc, u, wr, wc, fr, fq); }
};
struct EpiBranch {
    static constexpr bool PERM = false, AFTER_DRAIN = false;
    const bf16_t* G; bf16_t* Mg; int first;
    __device__ __forceinline__ void operator()(const f32x4 (&acc)[2][2][4][2], const Unit& u, int wr, int wc, int fr, int fq) const {
        const int row0 = u.pm * BM + wr * 64 + fr, col0 = u.pn * BM + wc * 32 + 8 * fq;
#pragma unroll
        for (int ai = 0; ai < 2; ++ai)
#pragma unroll
            for (int m = 0; m < 4; ++m) { if ((m & 1) == 0) asm volatile("" ::: "memory"); const int row = row0 + ai * HALF + m * 16;
#pragma unroll
                for (int bj = 0; bj < 2; ++bj) { const size_t off = (size_t)row * 1024 + col0 + bj * HALF;
                    f32x4 g0, g1; unpack8(*(const u32x4*)(G + off), g0, g1);
                    f32x4 o0 = acc[ai][bj][m][0] * g0, o1 = acc[ai][bj][m][1] * g1;
                    if (!first) { f32x4 p0, p1; unpack8(*(const u32x4*)(Mg + off), p0, p1); o0 = o0 + p0; o1 = o1 + p1; }
                    *(u32x4*)(Mg + off) = pack8(o0, o1); } }
    }
    __device__ __forceinline__ void fused(const f32x4 (&acc)[2][2][4][2], const Unit& u, int wr, int wc, int fr, int fq, PG8_LAS unsigned char*, int, int) const { (*this)(acc, u, wr, wc, fr, fq); }
};
struct EpiQKV {
    static constexpr bool PERM = false, AFTER_DRAIN = false;
    bf16_t* O; const float* ssq; const float* cosT; const float* sinT;
    const float *gqa, *gka, *gqb, *gkb, *gqc, *gkc; float* ksum; float c2;
    __device__ __forceinline__ void operator()(const f32x4 (&acc)[2][2][4][2], const Unit& u, int wr, int wc, int fr, int fq) const {
        const int g = 4 * u.pn + wc; const int row0 = u.pm * BM + wr * 64 + fr;
        int kind = 0; const float* gp = gqa; float osc = 1.f; bool dok = false;
        if (g < 4) { kind = 1; gp = gqa; osc = c2; } else if (g < 8) { kind = 1; gp = gka; dok = true; } else if (g < 12) { kind = 0; }
        else if (g < 16) { kind = 1; gp = gqb; osc = c2; } else if (g < 18) { kind = 1; gp = gkb; } else if (g < 20) { kind = 0; }
        else if (g < 28) { kind = 1; gp = gqc; osc = c2; } else if (g < 36) { kind = 1; gp = gkc; } else { kind = 0; }
        bf16_t* ob = O + 64 * g + 8 * fq;
        if (kind == 0) {
#pragma unroll
            for (int ai = 0; ai < 2; ++ai)
#pragma unroll
                for (int m = 0; m < 4; ++m) { if (m == 0) asm volatile("" ::: "memory"); const int row = row0 + ai * HALF + m * 16; const float rs = rstd_of(ssq, row);
#pragma unroll
                    for (int bj = 0; bj < 2; ++bj) *(u32x4*)(ob + (size_t)row * 2816 + 32 * bj) = pack8(acc[ai][bj][m][0] * rs, acc[ai][bj][m][1] * rs); }
        } else {
            f32x4 gv[2][2], cs[2][2];
#pragma unroll
            for (int bj = 0; bj < 2; ++bj)
#pragma unroll
                for (int n = 0; n < 2; ++n) { gv[bj][n] = *(const f32x4*)(gp + 32 * bj + 8 * fq + 4 * n); cs[bj][n] = (f32x4){0.f, 0.f, 0.f, 0.f}; }
#pragma unroll
            for (int ai = 0; ai < 2; ++ai)
#pragma unroll
                for (int m = 0; m < 4; ++m) { if (m == 0) asm volatile("" ::: "memory"); const int row = row0 + ai * HALF + m * 16; const float rs = rstd_of(ssq, row);
                    f32x4 v[2][2]; float ss = 0.f;
#pragma unroll
                    for (int bj = 0; bj < 2; ++bj)
#pragma unroll
                        for (int n = 0; n < 2; ++n) { v[bj][n] = acc[ai][bj][m][n] * rs; const f32x4 q = v[bj][n] * v[bj][n]; ss += (q[0] + q[1]) + (q[2] + q[3]); }
                    ss += __shfl_xor(ss, 16); ss += __shfl_xor(ss, 32);
                    const float rn = __builtin_amdgcn_rsqf(ss * (1.0f / 64.0f) + 1e-6f);
                    f32x4 o[2][2];
#pragma unroll
                    for (int n = 0; n < 2; ++n) { const f32x4 c = *(const f32x4*)(cosT + (size_t)row * 32 + 8 * fq + 4 * n), s = *(const f32x4*)(sinT + (size_t)row * 32 + 8 * fq + 4 * n);
                        const f32x4 y1 = v[0][n] * rn * gv[0][n], y2 = v[1][n] * rn * gv[1][n];
                        o[0][n] = y1 * c - y2 * s; o[1][n] = y2 * c + y1 * s; }
                    if (dok) {
#pragma unroll
                        for (int bj = 0; bj < 2; ++bj)
#pragma unroll
                            for (int n = 0; n < 2; ++n) cs[bj][n] = cs[bj][n] + o[bj][n]; }
#pragma unroll
                    for (int bj = 0; bj < 2; ++bj) *(u32x4*)(ob + (size_t)row * 2816 + 32 * bj) = pack8(o[bj][0] * osc, o[bj][1] * osc); }
            if (dok) {
#pragma unroll
                for (int bj = 0; bj < 2; ++bj)
#pragma unroll
                    for (int n = 0; n < 2; ++n)
#pragma unroll
                        for (int e = 0; e < 4; ++e) { float t = cs[bj][n][e]; t += __shfl_xor(t, 1); t += __shfl_xor(t, 2); t += __shfl_xor(t, 4); t += __shfl_xor(t, 8); cs[bj][n][e] = t; }
                if (fr == 0) { float* kp = ksum + ((size_t)((wr * 4 + (g - 4)) * 64 + u.pm)) * 64 + 8 * fq;
#pragma unroll
                    for (int bj = 0; bj < 2; ++bj)
#pragma unroll
                        for (int n = 0; n < 2; ++n) *(f32x4*)(kp + 32 * bj + 4 * n) = cs[bj][n]; }
            }
        }
    }
};

template <class Epi, class Sched, bool ALIGN_EPI = false, bool SP2 = false>
__device__ __forceinline__ void gemm_phase(PG8_LAS unsigned char* lds, const Gemm g, const Sched& S, const Epi& E) {
    int tid_ = threadIdx.x; asm volatile("" : "+v"(tid_)); const int tid = tid_, wid = __builtin_amdgcn_readfirstlane(tid >> 6), lane = tid & 63, wr = wid >> 2, wc = wid & 3, fr = lane & 15, fq = lane >> 4;
    const int K = g.K, nt = K / BK;
    unsigned voffA[2], voffB[2];
#pragma unroll
    for (int i = 0; i < 2; ++i) { int R, C; stage_rc(tid * 16 + i * 8192, R, C); const int Rb = Epi::PERM ? ((R & ~31) + perm32(R & 31)) : R;
        voffA[i] = (unsigned)(R * g.lda + C) * 2u; voffB[i] = (unsigned)(Rb * K + C) * 2u; }
    const size_t kstep = (size_t)(BK * 2);
    const size_t hstepB = (size_t)HALF * K * 2, hstepA = (size_t)HALF * g.lda * 2;
    const size_t tstepB = 2 * hstepB, tstepA = 2 * hstepA;
    const unsigned ldsw = (unsigned)wid * 1024u;
    const int aoff = lds_byte(wr * 64 + fr, fq * 8), boff = lds_byte(wc * 32 + fr, fq * 8);
#define PG8_SA(b, h) (((b) * 2 + (h)) * HTB)
#define PG8_SB(b, h) ((4 + (b) * 2 + (h)) * HTB)
#define PG8_STAGE(bufoff, gbase, voff) do { _Pragma("unroll") for (int _i = 0; _i < 2; ++_i) \
        __builtin_amdgcn_global_load_lds((const unsigned*)((const char*)(gbase) + (voff)[_i]), (PG8_LAS unsigned*)(lds + (bufoff) + ldsw + _i * 8192), 16, 0, 0); } while (0)
#define PG8_LDA(dst, b, h) do { _Pragma("unroll") for (int m = 0; m < 4; ++m) _Pragma("unroll") for (int k = 0; k < 2; ++k) dst[m][k] = *(const PG8_LAS bf16x8*)(lds + PG8_SA(b, h) + aoff + m * 2048 + k * 1024); } while (0)
#define PG8_LDB(dst, b, h) do { _Pragma("unroll") for (int n = 0; n < 2; ++n) _Pragma("unroll") for (int k = 0; k < 2; ++k) dst[n][k] = *(const PG8_LAS bf16x8*)(lds + PG8_SB(b, h) + boff + n * 2048 + k * 1024); } while (0)
#define PG8_MMA(ai, bj, At, Bt) do { __builtin_amdgcn_s_setprio(1); _Pragma("unroll") for (int m = 0; m < 4; ++m) _Pragma("unroll") for (int n = 0; n < 2; ++n) _Pragma("unroll") for (int k = 0; k < 2; ++k) \
        acc[ai][bj][m][n] = __builtin_amdgcn_mfma_f32_16x16x32_bf16(Bt[n][k], At[m][k], acc[ai][bj][m][n], 0, 0, 0); __builtin_amdgcn_s_setprio(0); } while (0)
#define PG8_WAIT_V(n) asm volatile("s_waitcnt vmcnt(" #n ")" ::: "memory")
#define PG8_WAIT_L(n) asm volatile("s_waitcnt lgkmcnt(" #n ")" ::: "memory")
#define PG8_BAR __builtin_amdgcn_s_barrier()
#define PG8_SCHED __builtin_amdgcn_sched_barrier(0)
    Unit cur, nxt; int ui = 0;
    if (!S.next(0, cur)) return;
    f32x4 acc[2][2][4][2];
#pragma unroll
    for (int a = 0; a < 2; ++a)
#pragma unroll
        for (int b = 0; b < 2; ++b)
#pragma unroll
            for (int m = 0; m < 4; ++m)
#pragma unroll
                for (int n = 0; n < 2; ++n) acc[a][b][m][n] = (f32x4){0.f, 0.f, 0.f, 0.f};
    bf16x8 At[4][2], B0[2][2], B1[2][2];
    const char* cA = (const char*)g.A + (size_t)cur.pm * tstepA; const char* cB = (const char*)g.Bt + (size_t)cur.pn * tstepB;
    S.a_ready(cur);
    if constexpr (SP2) {
        PG8_STAGE(PG8_SB(0, 0), cB, voffB); PG8_STAGE(PG8_SB(0, 1), cB + hstepB, voffB); PG8_STAGE(PG8_SA(0, 0), cA, voffA); PG8_STAGE(PG8_SA(0, 1), cA + hstepA, voffA);
        if (wr == 1) PG8_BAR;
        PG8_WAIT_V(2); PG8_BAR;
        PG8_STAGE(PG8_SB(1, 0), cB + kstep, voffB); PG8_STAGE(PG8_SA(1, 0), cA + kstep, voffA); PG8_STAGE(PG8_SB(1, 1), cB + hstepB + kstep, voffB);
        PG8_WAIT_V(6); PG8_BAR;
    } else {
        PG8_STAGE(PG8_SB(0, 0), cB, voffB); PG8_STAGE(PG8_SA(0, 0), cA, voffA); PG8_STAGE(PG8_SB(0, 1), cB + hstepB, voffB); PG8_STAGE(PG8_SA(0, 1), cA + hstepA, voffA);
        if (wr == 1) PG8_BAR;
        PG8_WAIT_V(4); PG8_BAR;
        PG8_STAGE(PG8_SB(1, 0), cB + kstep, voffB); PG8_STAGE(PG8_SA(1, 0), cA + kstep, voffA); PG8_STAGE(PG8_SB(1, 1), cB + hstepB + kstep, voffB);
        PG8_WAIT_V(6); PG8_BAR;
    }
    for (;;) {
        const bool has_next = S.next(ui + 1, nxt);
        const char* nA = has_next ? (const char*)g.A + (size_t)nxt.pm * tstepA : cA; const char* nB = has_next ? (const char*)g.Bt + (size_t)nxt.pn * tstepB : cB;
        for (int t = 0; t < nt; t += 2) {
            const bool last = (t == nt - 2);
            const char* a1 = cA + (size_t)(t + 1) * kstep;
            const char* a2 = last ? nA : cA + (size_t)(t + 2) * kstep; const char* b2 = last ? nB : cB + (size_t)(t + 2) * kstep;
            const char* a3 = a2 + kstep; const char* b3 = b2 + kstep;
            if (last && has_next) S.a_ready(nxt);
            if constexpr (SP2) {
            PG8_LDB(B0, 0, 0); PG8_LDB(B1, 0, 1); PG8_SCHED; PG8_LDA(At, 0, 0); PG8_STAGE(PG8_SA(1, 1), a1 + hstepA, voffA);
            PG8_WAIT_V(8); PG8_WAIT_L(0); PG8_BAR; PG8_MMA(0, 0, At, B0); PG8_MMA(0, 1, At, B1); PG8_BAR; PG8_SCHED;
            PG8_LDA(At, 0, 1); PG8_STAGE(PG8_SB(0, 0), b2, voffB); PG8_STAGE(PG8_SB(0, 1), b2 + hstepB, voffB); PG8_STAGE(PG8_SA(0, 0), a2, voffA);
            PG8_WAIT_V(8); PG8_WAIT_L(0); PG8_BAR; PG8_MMA(1, 0, At, B0); PG8_MMA(1, 1, At, B1); PG8_BAR; PG8_SCHED;
            PG8_LDB(B0, 1, 0); PG8_LDB(B1, 1, 1); PG8_SCHED; PG8_LDA(At, 1, 0); PG8_STAGE(PG8_SA(0, 1), a2 + hstepA, voffA);
            PG8_WAIT_V(8); PG8_WAIT_L(0); PG8_BAR; PG8_MMA(0, 0, At, B0); PG8_MMA(0, 1, At, B1); PG8_BAR; PG8_SCHED;
            PG8_LDA(At, 1, 1); PG8_STAGE(PG8_SB(1, 0), b3, voffB); PG8_STAGE(PG8_SB(1, 1), b3 + hstepB, voffB); PG8_STAGE(PG8_SA(1, 0), a3, voffA);
            PG8_WAIT_V(8); PG8_WAIT_L(0); PG8_BAR; PG8_MMA(1, 0, At, B0); PG8_MMA(1, 1, At, B1); PG8_BAR; PG8_SCHED;
            } else {
            PG8_LDB(B0, 0, 0); PG8_SCHED; PG8_LDA(At, 0, 0); PG8_STAGE(PG8_SA(1, 1), a1 + hstepA, voffA);
            PG8_WAIT_L(8); PG8_BAR; PG8_WAIT_L(0); PG8_MMA(0, 0, At, B0); PG8_BAR; PG8_SCHED;
            PG8_LDB(B1, 0, 1); PG8_STAGE(PG8_SB(0, 0), b2, voffB);
            PG8_BAR; PG8_WAIT_L(0); PG8_MMA(0, 1, At, B1); PG8_BAR;
            PG8_LDA(At, 0, 1); PG8_STAGE(PG8_SA(0, 0), a2, voffA);
            PG8_BAR; PG8_WAIT_L(0); PG8_MMA(1, 0, At, B0); PG8_BAR; PG8_SCHED;
            PG8_STAGE(PG8_SB(0, 1), b2 + hstepB, voffB);
            PG8_WAIT_V(6); PG8_BAR; PG8_MMA(1, 1, At, B1); PG8_BAR;
            PG8_LDB(B0, 1, 0); PG8_SCHED; PG8_LDA(At, 1, 0); PG8_STAGE(PG8_SA(0, 1), a2 + hstepA, voffA);
            PG8_WAIT_L(8); PG8_BAR; PG8_WAIT_L(0); PG8_MMA(0, 0, At, B0); PG8_BAR; PG8_SCHED;
            PG8_LDB(B1, 1, 1); PG8_STAGE(PG8_SB(1, 0), b3, voffB);
            PG8_BAR; PG8_WAIT_L(0); PG8_MMA(0, 1, At, B1); PG8_BAR;
            PG8_LDA(At, 1, 1); PG8_STAGE(PG8_SA(1, 0), a3, voffA);
            PG8_BAR; PG8_WAIT_L(0); PG8_MMA(1, 0, At, B0); PG8_BAR; PG8_SCHED;
            PG8_STAGE(PG8_SB(1, 1), b3 + hstepB, voffB);
            PG8_WAIT_V(6); PG8_BAR; PG8_MMA(1, 1, At, B1); PG8_BAR;
            }
        }
        if constexpr (ALIGN_EPI) { if (wr == 0) PG8_BAR; }
        if constexpr (!Epi::AFTER_DRAIN) { E(acc, cur, wr, wc, fr, fq); S.done(cur); }
        if (!has_next) break;
#pragma unroll
        for (int a = 0; a < 2; ++a)
#pragma unroll
            for (int b = 0; b < 2; ++b)
#pragma unroll
                for (int m = 0; m < 4; ++m)
#pragma unroll
                    for (int n = 0; n < 2; ++n) acc[a][b][m][n] = (f32x4){0.f, 0.f, 0.f, 0.f};
        cur = nxt; cA = nA; cB = nB; ++ui;
        if constexpr (ALIGN_EPI) { if (wr == 1) PG8_BAR; }
    }
    PG8_WAIT_V(0);
    if constexpr (!ALIGN_EPI) { if (wr == 0) PG8_BAR; }
    PG8_BAR;
    if constexpr (Epi::AFTER_DRAIN) { E.fused(acc, cur, wr, wc, fr, fq, lds, wid, lane); S.done(cur); }
#undef PG8_SA
#undef PG8_SB
#undef PG8_STAGE
#undef PG8_LDA
#undef PG8_LDB
#undef PG8_MMA
#undef PG8_WAIT_V
#undef PG8_WAIT_L
#undef PG8_BAR
#undef PG8_SCHED
}
}

#ifndef PG8_SP2
#define PG8_SP2 true
#endif
#ifndef PG8_ALIGN
#define PG8_ALIGN true
#endif

#include <hip/hip_bf16.h>
#include <cmath>
namespace attn_body {
using bf16=__hip_bfloat16;
using bf16x8=__attribute__((ext_vector_type(8)))short;
using s16x4=__attribute__((ext_vector_type(4)))short;
using f32x16=__attribute__((ext_vector_type(16)))float;
using u32x4=__attribute__((ext_vector_type(4)))unsigned;
constexpr int D=64,DM=2816,OPITCH=1536;
constexpr int NW=8,QBLK=32,QB=QBLK*NW,KVBLK=64;
constexpr int ATTN_PITCH=DM, ATTN_UNIT_ROWS=QB;
__device__ __forceinline__ int crow(int r,int hi){return (r&3)+8*(r>>2)+4*hi;}
#define SBAR() __builtin_amdgcn_sched_barrier(0)
constexpr float NEGV=-1000.0f;
__device__ __forceinline__ void cmask(f32x16&p0,f32x16&p1,int jb,int qrel,int hi){
  const float NEG=NEGV; int kb=64*jb+4*hi;
  #pragma unroll
  for(int r=0;r<16;++r){int kv=kb+(r&3)+8*(r>>2); if(kv>qrel)p0[r]=NEG; if(kv+32>qrel)p1[r]=NEG;}
}
__device__ __forceinline__ void swamask(f32x16&p0,f32x16&p1,int jb,int qrel,int hi){
  const float NEG=NEGV; int kb=64*jb+4*hi;
  #pragma unroll
  for(int r=0;r<16;++r){int kv=kb+(r&3)+8*(r>>2); if(kv>qrel||kv<qrel-127)p0[r]=NEG; if(kv+32>qrel||kv+32<qrel-127)p1[r]=NEG;}
}
__device__ __forceinline__ void mobamask(f32x16&p0,f32x16&p1,unsigned long long sel,int b){
  const float NEG=NEGV; const bool keep=((sel>>b)&1ull)!=0ull;
  #pragma unroll
  for(int r=0;r<16;++r){ p0[r]=keep?p0[r]:NEG; p1[r]=keep?p1[r]:NEG; }
}

constexpr int NSLOT=3, SLOTB=8192;
constexpr int LDS_K=0, LDS_V=NSLOT*SLOTB, LDS_WS=2*NSLOT*SLOTB, LDS_OST=LDS_WS+NW*64*4, LDS_BYTES=LDS_OST+NW*4096;
constexpr float C2=0.125f*1.4426950408889634f;
__device__ __forceinline__ void glds16(const void*gsrc,unsigned lds_dst){unsigned keep;
  asm volatile("s_mov_b32 %0, m0\n\ts_mov_b32 m0, %2\n\ts_nop 0\n\tglobal_load_lds_dwordx4 %1, off\n\ts_mov_b32 m0, %0":"=&s"(keep):"v"(gsrc),"s"(lds_dst):"memory");}
__device__ __forceinline__ float max3f(float a,float b,float c){float r;asm("v_max3_f32 %0, %1, %2, %3":"=v"(r):"v"(a),"v"(b),"v"(c));return r;}
__device__ __forceinline__ float max2f(float a,float b){float r;asm("v_max_f32_e32 %0, %1, %2":"=v"(r):"v"(a),"v"(b));return r;}
__device__ __forceinline__ float fadd_s(float a,float b){float r;asm("v_add_f32_e32 %0, %1, %2":"=v"(r):"v"(a),"v"(b));return r;}
__device__ __forceinline__ float fsub_s(float a,float b){float r;asm("v_sub_f32_e32 %0, %1, %2":"=v"(r):"v"(a),"v"(b));return r;}
typedef float f32x2_t __attribute__((ext_vector_type(2))); typedef __bf16 bf16x2_t __attribute__((ext_vector_type(2)));
__device__ __forceinline__ unsigned cvtpk_s(float lo,float hi){f32x2_t v={lo,hi};bf16x2_t b=__builtin_convertvector(v,bf16x2_t);return __builtin_bit_cast(unsigned,b);}
#define WAIT_BAR(N) asm volatile("s_waitcnt vmcnt(" #N ") lgkmcnt(0)\n\ts_barrier":::"memory")

__device__ __forceinline__ void qkt(f32x16&p0,f32x16&p1,const char*Kslot,const bf16x8*qr,const f32x16&negm,int r32,int hi){
  const char*kb=Kslot+hi*1024+r32*16;
  #pragma unroll
  for(int d0=0;d0<4;++d0){
    const bf16x8 b0=*reinterpret_cast<const bf16x8*>(kb+d0*2048);
    const bf16x8 b1=*reinterpret_cast<const bf16x8*>(kb+d0*2048+512);
    if(d0==0){p0=__builtin_amdgcn_mfma_f32_32x32x16_bf16(b0,qr[0],negm,0,0,0);p1=__builtin_amdgcn_mfma_f32_32x32x16_bf16(b1,qr[0],negm,0,0,0);}
    else{p0=__builtin_amdgcn_mfma_f32_32x32x16_bf16(b0,qr[d0],p0,0,0,0);p1=__builtin_amdgcn_mfma_f32_32x32x16_bf16(b1,qr[d0],p1,0,0,0);}}
}
typedef __attribute__((address_space(3))) const char* lds_cptr;
typedef short v4i16_t __attribute__((ext_vector_type(4)));
__device__ __forceinline__ void kload8(bf16x8*kf,lds_cptr kp){
  kf[0]=*(const __attribute__((address_space(3))) bf16x8*)(kp);      kf[1]=*(const __attribute__((address_space(3))) bf16x8*)(kp+512);
  kf[2]=*(const __attribute__((address_space(3))) bf16x8*)(kp+2048); kf[3]=*(const __attribute__((address_space(3))) bf16x8*)(kp+2560);
  kf[4]=*(const __attribute__((address_space(3))) bf16x8*)(kp+4096); kf[5]=*(const __attribute__((address_space(3))) bf16x8*)(kp+4608);
  kf[6]=*(const __attribute__((address_space(3))) bf16x8*)(kp+6144); kf[7]=*(const __attribute__((address_space(3))) bf16x8*)(kp+6656);
}
__device__ __forceinline__ void kload2(bf16x8*kf,lds_cptr kp,int j){ kf[2*j]=*(const __attribute__((address_space(3))) bf16x8*)(kp+j*2048); kf[2*j+1]=*(const __attribute__((address_space(3))) bf16x8*)(kp+j*2048+512); }
__device__ __forceinline__ s16x4 vtr(lds_cptr p){ return __builtin_bit_cast(s16x4,__builtin_amdgcn_ds_read_tr16_b64_v4i16((__attribute__((address_space(3))) v4i16_t*)p)); }
__device__ __forceinline__ float rowmax(const f32x16&p0,const f32x16&p1){
  float a=max3f(p0[0],p0[1],p1[0]),b=max3f(p0[2],p0[3],p1[1]);a=max3f(a,p1[2],p1[3]);
  #pragma unroll
  for(int r=4;r<16;r+=4){a=max3f(a,p0[r],p0[r+1]);b=max3f(b,p0[r+2],p0[r+3]);a=max3f(a,p1[r],p1[r+1]);b=max3f(b,p1[r+2],p1[r+3]);}
  const float m=max2f(a,b);
  auto rr=__builtin_amdgcn_permlane32_swap(__float_as_uint(m),__float_as_uint(m),false,false);
  return max2f(__uint_as_float(rr[0]),__uint_as_float(rr[1]));
}
__device__ __forceinline__ void pv(f32x16*o,int vb,bf16x8 pa0,bf16x8 pa1,bf16x8 pa2,bf16x8 pa3){
  #pragma unroll
  for(int d0=0;d0<2;++d0){s16x4 lo[4],hi[4];
    #pragma unroll
    for(int ks=0;ks<4;++ks){
      asm volatile("ds_read_b64_tr_b16 %0,%1 offset:%c2":"=&v"(lo[ks]):"v"(vb),"i"(d0*4096+ks*1024):"memory");
      asm volatile("ds_read_b64_tr_b16 %0,%1 offset:%c2":"=&v"(hi[ks]):"v"(vb),"i"(d0*4096+ks*1024+512):"memory");}
    asm volatile("s_waitcnt lgkmcnt(0)":::"memory");SBAR();
    #define PK(k) (bf16x8){lo[k][0],lo[k][1],lo[k][2],lo[k][3],hi[k][0],hi[k][1],hi[k][2],hi[k][3]}
    o[d0]=__builtin_amdgcn_mfma_f32_32x32x16_bf16(pa0,PK(0),o[d0],0,0,0);
    o[d0]=__builtin_amdgcn_mfma_f32_32x32x16_bf16(pa1,PK(1),o[d0],0,0,0);
    o[d0]=__builtin_amdgcn_mfma_f32_32x32x16_bf16(pa2,PK(2),o[d0],0,0,0);
    o[d0]=__builtin_amdgcn_mfma_f32_32x32x16_bf16(pa3,PK(3),o[d0],0,0,0);
    #undef PK
  }
}

#ifndef ATTN_STORE16
#define ATTN_STORE16(p,v) __builtin_nontemporal_store((v),(u32x4*)(p))
#endif
template<int MODE,int THRL> __device__ __forceinline__ void attn_unit(int qb,int t0,const bf16*Q,const bf16*__restrict__ K,const bf16*__restrict__ V,bf16*O,char*shm,const float*ksum,float sinkl2,const unsigned short*list=nullptr,int len=256,float*stat=nullptr){
  int tid_=threadIdx.x; asm volatile("":"+v"(tid_)); const int tid=tid_,lane=tid&63,r32=lane&31,hi=lane>>5; const int wid=__builtin_amdgcn_readfirstlane(tid>>6);
  const int q0=qb*QB;
  const bf16*Qw=Q+(long)(q0+wid*QBLK)*DM;
  const bf16*Kh=K+(long)t0*KVBLK*DM,*Vh=V+(long)t0*KVBLK*DM;
  const unsigned lds0=(unsigned)(uintptr_t)shm;
  float*wsf=(float*)(shm+LDS_WS)+wid*64;
  const bf16*ksrc=Kh+(long)lane*DM+wid*8;
  const bf16*vsrc=Vh+(long)(16*(wid&3)+(lane>>2))*DM+(wid>>2)*32+(lane&3)*8;
  const unsigned kdst=lds0+LDS_K+wid*1024, vdst=lds0+LDS_V+wid*1024;
  #define DMA_K(t,slot) glds16(ksrc+(long)(t)*KVBLK*DM,(unsigned)__builtin_amdgcn_readfirstlane(kdst+(slot)))
  #define DMA_V(t,slot) glds16(vsrc+(long)(t)*KVBLK*DM,(unsigned)__builtin_amdgcn_readfirstlane(vdst+(slot)))
  const int vb0=(int)(lds0+LDS_V)+((lane>>4)&1)*32+(lane&3)*8+(4*hi+((lane&15)>>2))*64;
  const char*Kbase=shm+LDS_K; bf16x8 kf[8];
  const lds_cptr shm3=(lds_cptr)shm; const lds_cptr kp0=shm3+LDS_K+hi*1024+r32*16; const lds_cptr vp0=shm3+LDS_V+((lane>>4)&1)*32+(lane&3)*8+(4*hi+((lane&15)>>2))*64;
  const int NT=(q0+QB)/KVBLK-t0;
  bf16x8 qr[4]; unsigned long long sel=0ull;
  const bf16*Qrow=Qw+(long)r32*DM;
  if(MODE==3){ const int p_=wid*QBLK+r32; const long trow_=list?(long)list[p_<len?p_:len-1]:(long)(q0+p_); Qrow=Q+trow_*DM; }
  if(MODE==1){
    #pragma unroll
    for(int d0=0;d0<4;++d0)qr[d0]=*reinterpret_cast<const bf16x8*>(&Qrow[d0*16+hi*8]);
    float*km=(float*)(shm+86016);
    #pragma unroll
    for(int i=0;i<8;++i){const int e=tid+512*i; km[e]=(ksum[e]+ksum[e+4*64*64])*(1.0f/256.0f);}
    asm volatile("s_waitcnt vmcnt(0) lgkmcnt(0)\n\ts_barrier":::"memory");
    float qf[32];
    #pragma unroll
    for(int d0=0;d0<4;++d0)
      #pragma unroll
      for(int j=0;j<8;++j)qf[d0*8+j]=__uint_as_float(((unsigned)(unsigned short)qr[d0][j])<<16);
    float t1=-INFINITY,t2=-INFINITY,t3=-INFINITY; int i1=-1,i2=-1,i3=-1;
    for(int b=0;b<qb;++b){
      const float*kr=km+b*64+hi*8; float g=0.f;
      #pragma unroll
      for(int d0=0;d0<4;++d0)
        #pragma unroll
        for(int j=0;j<8;++j)g+=qf[d0*8+j]*kr[d0*16+j];
      g+=__shfl_xor(g,32);
      if(g>t3){ if(g>t2){ t3=t2;i3=i2; if(g>t1){t2=t1;i2=i1;t1=g;i1=b;} else {t2=g;i2=b;} } else {t3=g;i3=b;} }
    }
    if(i1>=0)sel|=1ull<<i1; if(i2>=0)sel|=1ull<<i2; if(i3>=0)sel|=1ull<<i3;
  }
  DMA_K(0,0);DMA_V(0,0);DMA_K(1,SLOTB);
  if(MODE!=1){
    #pragma unroll
    for(int d0=0;d0<4;++d0)qr[d0]=*reinterpret_cast<const bf16x8*>(&Qrow[d0*16+hi*8]);
  }
  float mhat=0.f,l_reg=0.f;f32x16 o[2];o[0]=f32x16{};o[1]=f32x16{};f32x16 negm=f32x16{};asm volatile("":"+v"(negm));
  const int qrel=wid*QBLK+r32;
  #define CMASK(P0,P1,t) do{int jb_=(t)-(NT-4); if(MODE==3){ if(!list&&jb_>=0)cmask(P0,P1,jb_,qrel,hi); } else if(MODE==2){swamask(P0,P1,jb_,qrel,hi);} else if(jb_>=0){cmask(P0,P1,jb_,qrel,hi);} else if(MODE==1){mobamask(P0,P1,sel,(t)>>2);} }while(0)
  bool resc=false;
  #define START(P0,P1) do{ const float rm=rowmax(P0,P1); resc=false; \
    { const float dl=rm; mhat=fadd_s(mhat,dl); \
      _Pragma("unroll") for(int r=0;r<16;++r){P0[r]=fsub_s(P0[r],dl);P1[r]=fsub_s(P1[r],dl);} \
      _Pragma("unroll") for(int r=0;r<16;++r)negm[r]=-mhat; asm volatile("":"+v"(negm)); } \
    _Pragma("unroll") for(int r=0;r<16;++r)P0[r]=__builtin_amdgcn_exp2f(P0[r]); }while(0)
  #define RESC() do{ if(resc){ asm volatile("s_waitcnt lgkmcnt(0)":::"memory"); \
      _Pragma("unroll") for(int d_=0;d_<2;++d_) _Pragma("unroll") for(int r=0;r<16;++r)o[d_][r]*=wsf[crow(r,hi)]; } }while(0)
  f32x16 pA0,pA1,pB0,pB1;
  int sl_prev=0,sl_cur=0,sl_next=SLOTB;
  #define ROT() do{sl_prev=sl_cur;sl_cur=sl_next;sl_next=(sl_next==(NSLOT-1)*SLOTB)?0:sl_next+SLOTB;}while(0)
  DMA_K(2,2*SLOTB);
  WAIT_BAR(3);
  qkt(pA0,pA1,Kbase,qr,negm,r32,hi);asm volatile("s_nop 15\n\ts_nop 7":"+v"(pA0),"+v"(pA1));CMASK(pA0,pA1,0);
  START(pA0,pA1);
  _Pragma("unroll") for(int r=0;r<16;++r)pA1[r]=__builtin_amdgcn_exp2f(pA1[r]);
  WAIT_BAR(0);
  DMA_K(3,0);DMA_V(1,SLOTB);
  ROT();
  kload8(kf,kp0+sl_cur);
  WAIT_BAR(2);
  s16x4 vlo[8],vhi[8]; u32x4 pw0,pw1,pw2,pw3;
  #define PKW(P,B) cvtpk_s(P[B],P[B+1])
  #define PAF(k) __builtin_bit_cast(bf16x8,pw##k)
  #define VFR(i) (bf16x8){vlo[i][0],vlo[i][1],vlo[i][2],vlo[i][3],vhi[i][0],vhi[i][1],vhi[i][2],vhi[i][3]}
  #define PIN(x) asm volatile("":"+v"(x))
  #define MX3(a,b,c) __builtin_fmaxf(__builtin_fmaxf((a),(b)),(c))
  #define GAPA(MF,A0,A1,A2,A3,W0,W1,PW) do{ MF; sacc+=A0; sacc+=A1; sacc+=A2; sacc+=A3; PIN(sacc); W0; W1; PIN(PW); SBAR(); }while(0)
  #define EX(v) __builtin_amdgcn_exp2f(v)
  #define GAPB(MF,X,B) do{ MF; X[B]=EX(X[B]); X[B+1]=EX(X[B+1]); X[B+2]=EX(X[B+2]); X[B+3]=EX(X[B+3]); PIN(X); SBAR(); }while(0)
  #define VRD(i) do{ vlo[i]=vtr(vp_+(((i)>>2)*4096+((i)&3)*1024)); vhi[i]=vtr(vp_+(((i)>>2)*4096+((i)&3)*1024+512)); }while(0)
  #define KRD(G,j) do{ if(G){ kload2(kf,kp0+sl_next,j); SBAR(); } }while(0)
  #define STEP(C0,C1,P0,P1,t,GK,GV,GL) do{ SBAR(); \
    const lds_cptr vp_=vp0+sl_prev; \
    VRD(0); SBAR(); float sacc=(P0[0]+P0[1]); \
    GAPA(C0=__builtin_amdgcn_mfma_f32_32x32x16_bf16(kf[0],qr[0],negm,0,0,0), P0[2],P0[3],P0[4],P0[5],     pw0[0]=PKW(P0,0), pw0[1]=PKW(P0,2), pw0); \
    VRD(4); SBAR(); GAPA(C1=__builtin_amdgcn_mfma_f32_32x32x16_bf16(kf[1],qr[0],negm,0,0,0), P0[6],P0[7],P0[8],P0[9],     pw0[2]=PKW(P0,4), pw0[3]=PKW(P0,6), pw0); \
    VRD(1); SBAR(); GAPA(C0=__builtin_amdgcn_mfma_f32_32x32x16_bf16(kf[2],qr[1],C0,0,0,0),   P0[10],P0[11],P0[12],P0[13], pw1[0]=PKW(P0,8), pw1[1]=PKW(P0,10), pw1); \
    VRD(5); SBAR(); GAPA(C1=__builtin_amdgcn_mfma_f32_32x32x16_bf16(kf[3],qr[1],C1,0,0,0),   P0[14],P0[15],P1[0],P1[1],   pw1[2]=PKW(P0,12),pw1[3]=PKW(P0,14), pw1); \
    VRD(2); SBAR(); GAPA(C0=__builtin_amdgcn_mfma_f32_32x32x16_bf16(kf[4],qr[2],C0,0,0,0),   P1[2],P1[3],P1[4],P1[5],     pw2[0]=PKW(P1,0), pw2[1]=PKW(P1,2), pw2); \
    VRD(6); SBAR(); GAPA(C1=__builtin_amdgcn_mfma_f32_32x32x16_bf16(kf[5],qr[2],C1,0,0,0),   P1[6],P1[7],P1[8],P1[9],     pw2[2]=PKW(P1,4), pw2[3]=PKW(P1,6), pw2); \
    VRD(3); SBAR(); GAPA(C0=__builtin_amdgcn_mfma_f32_32x32x16_bf16(kf[6],qr[3],C0,0,0,0),   P1[10],P1[11],P1[12],P1[13], pw3[0]=PKW(P1,8), pw3[1]=PKW(P1,10), pw3); \
    VRD(7); SBAR(); GAPA(C1=__builtin_amdgcn_mfma_f32_32x32x16_bf16(kf[7],qr[3],C1,0,0,0),   P1[14],P1[15],0.f,0.f,       pw3[2]=PKW(P1,12),pw3[3]=PKW(P1,14), pw3); \
    l_reg+=sacc; \
    if(GK){DMA_K((t)+3,sl_cur);} if(GV){DMA_V((t)+1,sl_next);} \
    CMASK(C0,C1,t); \
    { float a=MX3(C0[0],C0[1],C1[0]),b=MX3(C0[2],C0[3],C1[1]); a=MX3(a,C1[2],C1[3]); \
      _Pragma("unroll") for(int r=4;r<16;r+=4){a=MX3(a,C0[r],C0[r+1]);b=MX3(b,C0[r+2],C0[r+3]);a=MX3(a,C1[r],C1[r+1]);b=MX3(b,C1[r+2],C1[r+3]);} \
      float rm=__builtin_fmaxf(a,b); { auto rr=__builtin_amdgcn_permlane32_swap(__float_as_uint(rm),__float_as_uint(rm),false,false); rm=__builtin_fmaxf(__uint_as_float(rr[0]),__uint_as_float(rr[1])); } \
      resc=false; \
      if(__builtin_expect(__any(rm>(float)THRL),0)){ const float dl=__builtin_fmaxf(rm,0.f); mhat+=dl; \
        _Pragma("unroll") for(int r=0;r<16;++r){C0[r]-=dl;C1[r]-=dl;} \
        _Pragma("unroll") for(int r=0;r<16;++r)negm[r]=-mhat; asm volatile("":"+v"(negm)); \
        const float f=__builtin_amdgcn_exp2f(-dl); l_reg*=f; if(hi==0)wsf[r32]=f; resc=true; } } \
    SBAR(); \
    GAPB(o[0]=__builtin_amdgcn_mfma_f32_32x32x16_bf16(PAF(0),VFR(0),o[0],0,0,0), C0,0); \
    GAPB(o[1]=__builtin_amdgcn_mfma_f32_32x32x16_bf16(PAF(0),VFR(4),o[1],0,0,0), C0,4); \
    KRD(GL,0); GAPB(o[0]=__builtin_amdgcn_mfma_f32_32x32x16_bf16(PAF(1),VFR(1),o[0],0,0,0), C0,8); \
    KRD(GL,1); GAPB(o[1]=__builtin_amdgcn_mfma_f32_32x32x16_bf16(PAF(1),VFR(5),o[1],0,0,0), C0,12); \
    KRD(GL,2); GAPB(o[0]=__builtin_amdgcn_mfma_f32_32x32x16_bf16(PAF(2),VFR(2),o[0],0,0,0), C1,0); \
    KRD(GL,3); GAPB(o[1]=__builtin_amdgcn_mfma_f32_32x32x16_bf16(PAF(2),VFR(6),o[1],0,0,0), C1,4); \
    GAPB(o[0]=__builtin_amdgcn_mfma_f32_32x32x16_bf16(PAF(3),VFR(3),o[0],0,0,0), C1,8); \
    GAPB(o[1]=__builtin_amdgcn_mfma_f32_32x32x16_bf16(PAF(3),VFR(7),o[1],0,0,0), C1,12); \
    }while(0)
  int t=1;
  #undef CMASK
  #define CMASK(P0,P1,t) do{ if(MODE==1){mobamask(P0,P1,sel,(t)>>2);} }while(0)
  for(;t+5<NT;t+=2){
    STEP(pB0,pB1,pA0,pA1,t,true,true,true);     WAIT_BAR(2); RESC(); ROT();
    STEP(pA0,pA1,pB0,pB1,t+1,true,true,true);   WAIT_BAR(2); RESC(); ROT();
  }
  #undef CMASK
  #define CMASK(P0,P1,t) do{int jb_=(t)-(NT-4); if(MODE==3){ if(!list&&jb_>=0)cmask(P0,P1,jb_,qrel,hi); } else if(MODE==2){swamask(P0,P1,jb_,qrel,hi);} else if(jb_>=0){cmask(P0,P1,jb_,qrel,hi);} else if(MODE==1){mobamask(P0,P1,sel,(t)>>2);} }while(0)
  #define ENDW(tt) do{ if((tt)+3<NT){WAIT_BAR(2);} else if((tt)+2<NT){WAIT_BAR(1);} else {WAIT_BAR(0);} }while(0)
  for(;t+1<NT;t+=2){
    STEP(pB0,pB1,pA0,pA1,t,(t+3<NT),(t+1<NT),(t+1<NT));       ENDW(t);   RESC(); ROT();
    STEP(pA0,pA1,pB0,pB1,t+1,(t+4<NT),(t+2<NT),(t+2<NT));     ENDW(t+1); RESC(); ROT();
  }
  STEP(pB0,pB1,pA0,pA1,NT-1,false,false,false); RESC();
  { float sacc=pB0[0]+pB0[1]; _Pragma("unroll") for(int r=2;r<16;++r)sacc+=pB0[r]; _Pragma("unroll") for(int r=0;r<16;++r)sacc+=pB1[r]; l_reg+=sacc;
    pw0=(u32x4){PKW(pB0,0),PKW(pB0,2),PKW(pB0,4),PKW(pB0,6)};pw1=(u32x4){PKW(pB0,8),PKW(pB0,10),PKW(pB0,12),PKW(pB0,14)};pw2=(u32x4){PKW(pB1,0),PKW(pB1,2),PKW(pB1,4),PKW(pB1,6)};pw3=(u32x4){PKW(pB1,8),PKW(pB1,10),PKW(pB1,12),PKW(pB1,14)};
    SBAR(); pv(o,vb0+sl_cur,PAF(0),PAF(1),PAF(2),PAF(3)); }
  #undef PKW
  #undef PAF
  #undef VFR
  #undef PIN
  #undef MX3
  #undef GAPA
  #undef GAPB
  #undef EX
  #undef VRD
  #undef KRD
  #undef STEP
  #undef ENDW
  {auto rr=__builtin_amdgcn_permlane32_swap(__float_as_uint(l_reg),__float_as_uint(l_reg),false,false);l_reg=__uint_as_float(rr[0])+__uint_as_float(rr[1]);}
  if(MODE==2)l_reg+=__builtin_amdgcn_exp2f(sinkl2-mhat);
  if(MODE==3){ const int p_=wid*QBLK+r32; if(hi==0&&p_<len)stat[p_]=mhat+__builtin_amdgcn_logf(l_reg); }
  if(hi==0)wsf[32+r32]=l_reg;asm volatile("s_waitcnt lgkmcnt(0)":::"memory");
  float rli[16];
  #pragma unroll
  for(int r=0;r<16;++r)rli[r]=__builtin_amdgcn_rcpf(wsf[32+crow(r,hi)]);
  constexpr int OP_=(MODE==3)?64:OPITCH; bf16*Ow=(MODE==3)?O+(long)(wid*QBLK)*OP_:O+(long)(q0+wid*QBLK)*OP_;
  { bf16*stg=(bf16*)(shm+LDS_OST)+wid*2048;
    #pragma unroll
    for(int r=0;r<16;++r){const int orow=crow(r,hi);
      #pragma unroll
      for(int d0=0;d0<2;++d0)stg[orow*64+d0*32+r32]=__float2bfloat16(o[d0][r]*rli[r]);}
    asm volatile("s_waitcnt lgkmcnt(0)":::"memory");
    #pragma unroll
    for(int i=0;i<4;++i){const int row=i*8+(lane>>3),ch=lane&7; const u32x4 v=*(const u32x4*)(stg+row*64+ch*8); if(MODE!=3||wid*QBLK+row<len)ATTN_STORE16(Ow+(long)row*OP_+ch*8,v);} }
  asm volatile("s_waitcnt lgkmcnt(0)\n\ts_barrier":::"memory");
  #undef DMA_K
  #undef DMA_V
  #undef CMASK
  #undef START
  #undef RESC
  #undef ROT
}

__device__ __forceinline__ void moba_gate(int qb,const bf16*Q,char*shm,const float*ksum,unsigned*cnt,int*seltmp){
  typedef __attribute__((address_space(3))) int* lds_iptr;
  int tid_=threadIdx.x; asm volatile("":"+v"(tid_)); const int tid=tid_,lane=tid&63,r32=lane&31,hi=lane>>5; const int wid=__builtin_amdgcn_readfirstlane(tid>>6);
  const int t=qb*QB+wid*QBLK+r32; const bf16*Qrow=Q+(long)t*DM; bf16x8 qr[4];
  #pragma unroll
  for(int d0=0;d0<4;++d0)qr[d0]=*reinterpret_cast<const bf16x8*>(&Qrow[d0*16+hi*8]);
  float*km=(float*)(shm+86016);
  const lds_iptr hist=(lds_iptr)((lds_cptr)shm+102400);
  #pragma unroll
  for(int i=0;i<8;++i){const int e=tid+512*i; km[e]=(ksum[e]+ksum[e+4*64*64])*(1.0f/256.0f);}
  if(tid<64)hist[tid]=0;
  asm volatile("s_waitcnt vmcnt(0) lgkmcnt(0)\n\ts_barrier":::"memory");
  float qf[32];
  #pragma unroll
  for(int d0=0;d0<4;++d0)
    #pragma unroll
    for(int j=0;j<8;++j)qf[d0*8+j]=__uint_as_float(((unsigned)(unsigned short)qr[d0][j])<<16);
  float t1=-INFINITY,t2=-INFINITY,t3=-INFINITY; int i1=-1,i2=-1,i3=-1;
  for(int b=0;b<qb;++b){
    const float*kr=km+b*64+hi*8; float g=0.f;
    #pragma unroll
    for(int d0=0;d0<4;++d0)
      #pragma unroll
      for(int j=0;j<8;++j)g+=qf[d0*8+j]*kr[d0*16+j];
    g+=__shfl_xor(g,32);
    if(g>t3){ if(g>t2){ t3=t2;i3=i2; if(g>t1){t2=t1;i2=i1;t1=g;i1=b;} else {t2=g;i2=b;} } else {t3=g;i3=b;} }
  }
  int k1=0,k2=0,k3=0;
  if(hi==0){ if(i1>=0)k1=__hip_atomic_fetch_add(hist+i1,1,__ATOMIC_RELAXED,__HIP_MEMORY_SCOPE_WORKGROUP);
             if(i2>=0)k2=__hip_atomic_fetch_add(hist+i2,1,__ATOMIC_RELAXED,__HIP_MEMORY_SCOPE_WORKGROUP);
             if(i3>=0)k3=__hip_atomic_fetch_add(hist+i3,1,__ATOMIC_RELAXED,__HIP_MEMORY_SCOPE_WORKGROUP); }
  asm volatile("s_waitcnt vmcnt(0) lgkmcnt(0)\n\ts_barrier":::"memory");
  if(tid<64){ const int n=hist[tid]; hist[64+tid]=n>0?(int)atomicAdd(cnt+tid,(unsigned)n):0; }
  asm volatile("s_waitcnt vmcnt(0) lgkmcnt(0)\n\ts_barrier":::"memory");
  if(hi==0){ int v1=-1,v2=-1,v3=-1;
    if(i1>=0)v1=(i1<<16)|(hist[64+i1]+k1);
    if(i2>=0)v2=(i2<<16)|(hist[64+i2]+k2);
    if(i3>=0)v3=(i3<<16)|(hist[64+i3]+k3);
    seltmp[(long)t*4+0]=v1; seltmp[(long)t*4+1]=v2; seltmp[(long)t*4+2]=v3; }
  asm volatile("s_waitcnt vmcnt(0) lgkmcnt(0)\n\ts_barrier":::"memory");
}
constexpr int ATTN_LDS_BYTES=LDS_BYTES;
#undef SBAR
#undef WAIT_BAR
}

namespace cg = cooperative_groups;
constexpr int NWAVES = 8;
constexpr int M = 16384, DMODEL = 1024, DFF = 2816, QKVW = 2816, OPW = 1536;
constexpr size_t MiB = 1u << 20;
constexpr size_t WS_BAR = 512 * 1024;
constexpr size_t WS_CTL = 0;
constexpr size_t WS_SSQ = 244 * MiB;
constexpr size_t WS_KSUM = 2 * MiB;
constexpr size_t WS_COS = 3 * MiB, WS_SIN = 5 * MiB;
constexpr size_t WS_W = 8 * MiB;
constexpr size_t W_GU1 = 0, W_D1 = W_GU1 + (size_t)5632 * 1024 * 2, W_QKV = W_D1 + (size_t)1024 * 2816 * 2, W_G = W_QKV + (size_t)2816 * 1024 * 2,
                 W_BA = W_G + (size_t)3 * 1024 * 1024 * 2, W_BB = W_BA + (size_t)1024 * 256 * 2, W_BC = W_BB + (size_t)1024 * 256 * 2, W_O = W_BC + (size_t)1024 * 512 * 2,
                 W_GU2 = W_O + (size_t)1024 * 1024 * 2, W_D2 = W_GU2 + (size_t)5632 * 1024 * 2, W_END = W_D2 + (size_t)1024 * 2816 * 2;
static_assert(W_END <= 52 * MiB, "weights");
constexpr size_t WS_XB = 60 * MiB;
constexpr size_t WS_R1 = 92 * MiB;
constexpr size_t WS_OB = 180 * MiB;
constexpr size_t WS_OC = 228 * MiB;
constexpr size_t WS_OCN = WS_R1 + 64 * MiB;
constexpr size_t WS_MSTAT = 252 * MiB;
constexpr size_t WS_MSEL = 253 * MiB;
constexpr size_t WS_MLIST = 254 * MiB;
constexpr size_t WS_END = 255 * MiB;
constexpr int RING_BYTES = 131072, MISC_OFF = RING_BYTES, LDS_BYTES = 147456;
constexpr int KM_OFF = 86016;
static_assert(attn_body::ATTN_LDS_BYTES <= KM_OFF && KM_OFF + 16384 <= RING_BYTES, "lds map");

#define LAS __attribute__((address_space(3)))
typedef unsigned short bf16;
typedef unsigned v4u __attribute__((ext_vector_type(4)));
typedef float f32x4 __attribute__((ext_vector_type(4)));
#define LDS_WAIT() asm volatile("s_waitcnt lgkmcnt(0)" ::: "memory")
__device__ __forceinline__ unsigned f2bf(float f) { unsigned u = __builtin_bit_cast(unsigned, f); return (u + 0x7fffu + ((u >> 16) & 1u)) >> 16; }
__device__ __forceinline__ unsigned pk2(float lo, float hi) { return f2bf(lo) | (f2bf(hi) << 16); }
__device__ __forceinline__ float wave_sum(float v) {
#pragma unroll
    for (int o = 1; o < 64; o <<= 1) v += __shfl_xor(v, o);
    return v;
}

__device__ __forceinline__ void conv_item(const float* W, int ldw, int col0, int ncols, int K, const float* gain, int mode, int bsel, bf16* WT, LAS float* scr, int item, int lane) {
    const int nblk = ncols / 32, kb = item / nblk, nb = item % nblk, k0 = 64 * kb, n0 = col0 + 32 * nb;
    { float wv[32]; const float* wp = W + (size_t)(k0 + (lane >> 5)) * ldw + n0 + (lane & 31);
#pragma unroll
      for (int i = 0; i < 32; ++i) wv[i] = __builtin_nontemporal_load(&wp[(size_t)(2 * i) * ldw]);
      if (gain) {
#pragma unroll
          for (int i = 0; i < 32; ++i) wv[i] *= gain[k0 + 2 * i + (lane >> 5)]; }
#pragma unroll
      for (int i = 0; i < 32; ++i) scr[(2 * i + (lane >> 5)) * 33 + (lane & 31)] = wv[i]; }
    LDS_WAIT(); asm volatile("" ::: "memory");
    int pbase;
    if (mode == 0) pbase = 32 * nb; else if (mode == 1) pbase = 256 * (nb >> 3) + 128 * (nb & 1) + 32 * ((nb >> 1) & 3); else pbase = 256 * (nb >> 2) + 128 * bsel + 32 * (nb & 3);
    const int c = lane & 7;
#pragma unroll
    for (int j = 0; j < 4; ++j) { const int n = (lane >> 3) + 8 * j; const LAS float* s = scr + (8 * c) * 33 + n;
        const int prow = pbase + 16 * ((n >> 2) & 1) + 4 * (n >> 3) + (n & 3);
        v4u o; o.x = pk2(s[0 * 33], s[1 * 33]); o.y = pk2(s[2 * 33], s[3 * 33]); o.z = pk2(s[4 * 33], s[5 * 33]); o.w = pk2(s[6 * 33], s[7 * 33]);
        *(v4u*)(WT + (size_t)prow * K + k0 + 8 * c) = o; }
    LDS_WAIT(); asm volatile("" ::: "memory");
}

struct Args { const float* in[27]; float* out; unsigned char* ws; };

template <class ArgsRef> __device__ __forceinline__ void conv_layer(const ArgsRef& a, int l, unsigned char* wsb, LAS float* scr, int gw, int NGW, int lane, int mi_lo, int mi_hi) {
    bf16* WB = (bf16*)(wsb + WS_W);
#pragma nounroll
    for (int mi = mi_lo; mi < mi_hi; ++mi) {
        const float* W; int ldw, col0 = 0, ncols, K, mode = 0, bsel = 0; const float* gain = nullptr; size_t dst;
        switch (mi) {
            case 0: W = a.in[2] + (size_t)l * 1024 * 2816; ldw = 2816; ncols = 2816; K = 1024; gain = a.in[1] + l * 1024; mode = 2; bsel = 0; dst = W_GU1; break;
            case 1: W = a.in[3] + (size_t)l * 1024 * 2816; ldw = 2816; ncols = 2816; K = 1024; gain = a.in[1] + l * 1024; mode = 2; bsel = 1; dst = W_GU1; break;
            case 2: W = a.in[4] + (size_t)l * 2816 * 1024; ldw = 1024; ncols = 1024; K = 2816; dst = W_D1; break;
            case 3: W = a.in[6] + (size_t)l * 1024 * 5888; ldw = 5888; ncols = 2816; K = 1024; gain = a.in[5] + l * 1024; mode = 1; dst = W_QKV; break;
            case 4: W = a.in[6] + (size_t)l * 1024 * 5888; ldw = 5888; col0 = 2816; ncols = 1024; K = 1024; gain = a.in[5] + l * 1024; dst = W_G; break;
            case 5: W = a.in[6] + (size_t)l * 1024 * 5888; ldw = 5888; col0 = 3840; ncols = 1024; K = 1024; gain = a.in[5] + l * 1024; dst = W_G + (size_t)1024 * 1024 * 2; break;
            case 6: W = a.in[6] + (size_t)l * 1024 * 5888; ldw = 5888; col0 = 4864; ncols = 1024; K = 1024; gain = a.in[5] + l * 1024; dst = W_G + (size_t)2 * 1024 * 1024 * 2; break;
            case 7: W = a.in[19] + (size_t)l * 256 * 1024; ldw = 1024; ncols = 1024; K = 256; dst = W_BA; break;
            case 8: W = a.in[20] + (size_t)l * 256 * 1024; ldw = 1024; ncols = 1024; K = 256; dst = W_BB; break;
            case 9: W = a.in[21] + (size_t)l * 512 * 1024; ldw = 1024; ncols = 1024; K = 512; dst = W_BC; break;
            case 10: W = a.in[22] + (size_t)l * 1024 * 1024; ldw = 1024; ncols = 1024; K = 1024; dst = W_O; break;
            case 11: W = a.in[24] + (size_t)l * 1024 * 2816; ldw = 2816; ncols = 2816; K = 1024; gain = a.in[23] + l * 1024; mode = 2; bsel = 0; dst = W_GU2; break;
            case 12: W = a.in[25] + (size_t)l * 1024 * 2816; ldw = 2816; ncols = 2816; K = 1024; gain = a.in[23] + l * 1024; mode = 2; bsel = 1; dst = W_GU2; break;
            default: W = a.in[26] + (size_t)l * 2816 * 1024; ldw = 1024; ncols = 1024; K = 2816; dst = W_D2; break;
        }
        const int nitems = (K / 64) * (ncols / 32);
        bf16* WT = (bf16*)((unsigned char*)WB + dst);
        for (int it = gw; it < nitems; it += NGW) conv_item(W, ldw, col0, ncols, K, gain, mode, bsel, WT, scr, it, lane);
    }
}

constexpr int N_HEAVY = 64 * 20, N_UNITS = N_HEAVY + 256;
constexpr float LOG2E = 1.4426950408889634f;

#define XB_TMO      128
#define XB_XCNT(j)  (256  + 64 * (j))
#define XB_XSUB(j)  (1280 + 64 * (j))
#define XB_XGEN(j)  (2304 + 64 * (j))
#define XB_TOP      3328
#define XB_TOPGEN   3392
#define XCD_BAR_WORDS 3456
#define XB_SPIN_CAP (1u << 18)

__device__ __forceinline__ unsigned xb_ld(unsigned* p)              { return __hip_atomic_load(p, __ATOMIC_RELAXED, __HIP_MEMORY_SCOPE_AGENT); }
__device__ __forceinline__ unsigned xb_add(unsigned* p, unsigned v) { return __hip_atomic_fetch_add(p, v, __ATOMIC_RELAXED, __HIP_MEMORY_SCOPE_AGENT); }
__device__ __forceinline__ unsigned xb_xcc_id() { return (unsigned)__builtin_amdgcn_s_getreg((3 << 11) | 20) & 0xFu; }
#define XB_SPIN(cond, bar) do { unsigned _sp = 0; while (cond) { __builtin_amdgcn_s_sleep(1); \
    if ((++_sp & 255u) == 0u) { if (xb_ld(&(bar)[XB_TMO])) break; if (_sp > XB_SPIN_CAP) { atomicAdd(&(bar)[XB_TMO], 1u); break; } } } } while (0)

struct XcdBarrier {
    unsigned* bar; unsigned x;
    volatile LAS unsigned* st;
};

__device__ __forceinline__ XcdBarrier xcd_barrier_post(unsigned* bar, volatile LAS unsigned* st) {
    XcdBarrier b; b.bar = bar; b.x = xb_xcc_id(); b.st = st;
    if (threadIdx.x == 0) (void)xb_add(&bar[XB_XCNT(b.x)], 1u);
    return b;
}
__device__ __forceinline__ void xcd_barrier_complete(unsigned* bar, unsigned x, unsigned& nloc, unsigned& nx) {
    const unsigned G = gridDim.x * gridDim.y * gridDim.z;
    unsigned sum, cnt, mine, sp = 0u;
    for (;;) {
        sum = 0u; cnt = 0u; mine = 0u;
#pragma unroll
        for (unsigned j = 0; j < 16; ++j) { const unsigned c = xb_ld(&bar[XB_XCNT(j)]); sum += c; cnt += (c > 0u) ? 1u : 0u; mine = (j == x) ? c : mine; }
        if (sum == G) break;
        __builtin_amdgcn_s_sleep(1);
        if ((++sp & 255u) == 0u) { if (xb_ld(&bar[XB_TMO])) break; if (sp > XB_SPIN_CAP) { atomicAdd(&bar[XB_TMO], 1u); break; } }
    }
    nloc = mine > 0u ? mine : 1u; nx = cnt > 0u ? cnt : 1u;
}

__device__ __forceinline__ void xcd_barrier(const XcdBarrier& b) {
    asm volatile("s_waitcnt vmcnt(0)" ::: "memory");
    __syncthreads();
    if (threadIdx.x == 0) {
        unsigned* bar = b.bar;
        __builtin_amdgcn_s_waitcnt(0);
        unsigned nloc = b.st[0], nx = b.st[1];
        if (nloc == 0u) { xcd_barrier_complete(bar, b.x, nloc, nx); b.st[0] = nloc; b.st[1] = nx; }
        const unsigned old = xb_add(&bar[XB_XSUB(b.x)], 1u);
        const unsigned gen = old / nloc;
        if (old + 1u == (gen + 1u) * nloc) {
            __builtin_amdgcn_fence(__ATOMIC_RELEASE, "agent");
            asm volatile("s_waitcnt vmcnt(0)" ::: "memory");
            const unsigned og = xb_add(&bar[XB_TOP], 1u);
            const unsigned tg = og / nx;
            if (og + 1u == (tg + 1u) * nx) xb_add(&bar[XB_TOPGEN], 1u);
            else XB_SPIN(xb_ld(&bar[XB_TOPGEN]) == tg, bar);
            __builtin_amdgcn_fence(__ATOMIC_ACQUIRE, "agent");
            xb_add(&bar[XB_XGEN(b.x)], 1u);
            asm volatile("s_waitcnt vmcnt(0)" ::: "memory");
        } else {
            XB_SPIN(xb_ld(&bar[XB_XGEN(b.x)]) == gen, bar);
            __builtin_amdgcn_fence(__ATOMIC_ACQUIRE, "agent");
            asm volatile("s_waitcnt vmcnt(0)" ::: "memory");
        }
    }
    __syncthreads();
}

__device__ __forceinline__ int opaque_tid() { int t = threadIdx.x; asm volatile("" : "+v"(t)); return t; }
#define GRID_SYNC() do { XcdBarrier xb_; xb_.bar = (unsigned*)(ARGS().ws + WS_BAR); xb_.x = xb_xcc_id(); xb_.st = (volatile LAS unsigned*)(ldsl + MISC_OFF) + 8; xcd_barrier(xb_); } while (0)
__device__ __forceinline__ int opaque_s(int v) { asm volatile("" : "+s"(v)); return v; }
typedef const __attribute__((address_space(4))) Args* KArgsPtr;
__device__ __forceinline__ KArgsPtr opaque_kargs() { KArgsPtr p = (KArgsPtr)__builtin_amdgcn_kernarg_segment_ptr(); asm volatile("" : "+s"(p)); return p; }
#define ARGS() (*opaque_kargs())
#define WSPTR() ({ unsigned char* w_ = ARGS().ws; asm volatile("" : "+s"(w_)); w_; })
__global__ void __launch_bounds__(NWAVES * 64, 2) mega_fwd(Args args_) {
    extern __shared__ __attribute__((aligned(16))) unsigned char lds[];
    cg::grid_group grid = cg::this_grid();
    LAS unsigned char* ldsl = (LAS unsigned char*)lds;
    if (threadIdx.x == 0) { volatile LAS unsigned* mq0_ = (volatile LAS unsigned*)(ldsl + MISC_OFF); mq0_[8] = 0u; mq0_[9] = 0u; }
    __syncthreads();
    (void)xcd_barrier_post((unsigned*)(ARGS().ws + WS_BAR), (volatile LAS unsigned*)(ldsl + MISC_OFF) + 8);
    grid.sync();
    const int G0 = gridDim.x, bx0 = blockIdx.x;
#define G opaque_s(G0)
#define bx opaque_s(bx0)

    {
        unsigned char* ws = WSPTR();
        const int tid = opaque_tid(), lane = tid & 63, wave = __builtin_amdgcn_readfirstlane(tid >> 6);
        const int gw = bx * NWAVES + wave, NGW = G * NWAVES;
        unsigned* ctl = (unsigned*)(ws + WS_CTL); float* ssq = (float*)(ws + WS_SSQ);
        float* cosT = (float*)(ws + WS_COS); float* sinT = (float*)(ws + WS_SIN);
        bf16* XB = (bf16*)(ws + WS_XB);
        if (bx == 0) for (int i = tid; i < 4096; i += NWAVES * 64) ctl[i] = 0u;
        for (int i = bx * (NWAVES * 64) + tid; i < M * 32; i += G * NWAVES * 64) {
            const int pos = i >> 5, fi = i & 31;
            const float invf = exp2f(-(float)fi * (13.287712379549449f / 32.0f));
            const float ang = (float)pos * invf;
            const double rev = (double)ang * 0.15915494309189535; const double fr_ = rev - rint(rev);
            const float f = (float)fr_;
            cosT[i] = __builtin_amdgcn_cosf(f); sinT[i] = __builtin_amdgcn_sinf(f);
        }
        for (int m = gw; m < M; m += NGW) {
            const f32x4* xr = (const f32x4*)(ARGS().in[0] + (size_t)m * 1024) + lane;
            unsigned long long* o8 = (unsigned long long*)(XB + (size_t)m * 1024) + lane; float s = 0.f;
            f32x4 v[4];
#pragma unroll
            for (int j = 0; j < 4; ++j) v[j] = __builtin_nontemporal_load(&xr[64 * j]);
#pragma unroll
            for (int j = 0; j < 4; ++j) { s += (v[j].x * v[j].x + v[j].y * v[j].y) + (v[j].z * v[j].z + v[j].w * v[j].w);
                o8[64 * j] = (unsigned long long)pk2(v[j].x, v[j].y) | ((unsigned long long)pk2(v[j].z, v[j].w) << 32); }
            s = wave_sum(s); if (lane < 4) ssq[(size_t)m * 4 + lane] = lane == 0 ? s : 0.f;
        }
        conv_layer(ARGS(), 0, ws, (LAS float*)(ldsl + wave * 16384), gw, NGW, lane, 0, 3);
    }
    GRID_SYNC();

#pragma nounroll
    for (int step = 0; step < 6; ++step) {
        if (step % 3 != 1) {
            { unsigned char* ws = WSPTR(); const int kind = step % 3;
              pg8::Gemm g{(const bf16*)(ws + WS_XB), (const bf16*)(ws + WS_W + (kind == 0 ? W_GU1 : W_GU2)), M, 5632, 1024, 1024}; pg8::StaticOrder S; S.init(M, 5632, G, bx);
              pg8::EpiFFNUp E{(bf16*)(ws + WS_R1), (const float*)(ws + WS_SSQ) + (size_t)step * M * 4};
              pg8::gemm_phase<pg8::EpiFFNUp, pg8::StaticOrder, true, true>(ldsl, g, S, E); }
            if (step != 5) {
                const int Gv = G, c = bx; const int rounds = (1408 + Gv - 1) / Gv, first_short = 1408 - (rounds - 1) * Gv;
                const bool all = first_short >= Gv;
                if (all || c >= first_short) {
                    unsigned char* ws = WSPTR(); const int tid = opaque_tid(), lane = tid & 63, wave = __builtin_amdgcn_readfirstlane(tid >> 6);
                    const int idx = all ? c : c - first_short, cnt = all ? Gv : Gv - first_short;
                    conv_layer(ARGS(), step == 0 ? 0 : 1, ws, (LAS float*)(ldsl + wave * 16384), idx * NWAVES + wave, cnt * NWAVES, lane, step == 0 ? 3 : (step == 2 ? 0 : 11), step == 0 ? 11 : (step == 2 ? 11 : 14));
                } }
            GRID_SYNC();
            { unsigned char* ws = WSPTR(); const int kind = step % 3;
              pg8::Gemm g{(const bf16*)(ws + WS_R1), (const bf16*)(ws + WS_W + (kind == 0 ? W_D1 : W_D2)), M, 1024, 2816, 2816}; pg8::StaticOrder S; S.init(M, 1024, G, bx);
              pg8::EpiResid E{step == 0 ? ARGS().in[0] : (const float*)ARGS().out, ARGS().out, (bf16*)(ws + WS_XB), (float*)(ws + WS_SSQ) + (size_t)(step + 1) * M * 4, 0.5f};
              pg8::gemm_phase<pg8::EpiResid, pg8::StaticOrder, false, true>(ldsl, g, S, E); }
            if (step != 5) GRID_SYNC();
        } else {
            { unsigned char* ws = WSPTR(); const int l = step / 3;
              pg8::Gemm g{(const bf16*)(ws + WS_XB), (const bf16*)(ws + WS_W + W_QKV), M, 2816, 1024, 1024}; pg8::StaticOrder S; S.init(M, 2816, G, bx);
              pg8::EpiQKV E{(bf16*)(ws + WS_R1), (const float*)(ws + WS_SSQ) + (size_t)step * M * 4, (const float*)(ws + WS_COS), (const float*)(ws + WS_SIN),
                            ARGS().in[7] + l * 64, ARGS().in[8] + l * 64, ARGS().in[9] + l * 64, ARGS().in[10] + l * 64, ARGS().in[12] + l * 64, ARGS().in[13] + l * 64, (float*)(ws + WS_KSUM), attn_body::C2};
              pg8::gemm_phase<pg8::EpiQKV, pg8::StaticOrder, true, true>(ldsl, g, S, E); }
            if (step == 1) {
                const int Gv = G, c = bx; const int rounds = (704 + Gv - 1) / Gv, first_short = 704 - (rounds - 1) * Gv; const bool all = first_short >= Gv;
                if (all || c >= first_short) {
                    unsigned char* ws = WSPTR(); const int tid = opaque_tid(), lane = tid & 63, wave = __builtin_amdgcn_readfirstlane(tid >> 6);
                    const int idx = all ? c : c - first_short, cnt = all ? Gv : Gv - first_short;
                    conv_layer(ARGS(), 0, ws, (LAS float*)(ldsl + wave * 16384), idx * NWAVES + wave, cnt * NWAVES, lane, 11, 14);
                } }
            GRID_SYNC();
            { unsigned char* ws = WSPTR(); const int l = step / 3;
              const attn_body::bf16* QKV = (const attn_body::bf16*)(ws + WS_R1);
              for (int u = bx; u < 256; u += G) { const int h = u >> 6, qb = u & 63;
                  attn_body::moba_gate(qb, QKV + 64 * h, (char*)lds, (const float*)(ws + WS_KSUM) + (size_t)h * 64 * 64, (unsigned*)(ws + WS_CTL) + 3072 + 256 * l + 64 * h, (int*)(ws + WS_MSEL) + (size_t)h * 16384 * 4); } }
            GRID_SYNC();
            { unsigned char* ws = WSPTR(); const int l = step / 3; const int tid = opaque_tid();
              volatile LAS int* T = (volatile LAS int*)(ldsl + MISC_OFF + 1024);
              const unsigned* cnt = (const unsigned*)(ws + WS_CTL) + 3072 + 256 * l;
              if (tid < 256) T[512 + tid] = 256 + (int)__hip_atomic_load(cnt + tid, __ATOMIC_RELAXED, __HIP_MEMORY_SCOPE_AGENT);
              __syncthreads();
              if (tid < 4) { int o = 0, c = 0; for (int b = 0; b < 64; ++b) { const int len = T[512 + tid * 64 + b]; T[tid * 64 + b] = o; T[256 + tid * 64 + b] = c; o += len; c += (len + 255) >> 8; } T[768 + tid] = c; }
              __syncthreads();
              if (tid < 256) { const int h = tid >> 6; const int add = (h > 0 ? T[768] : 0) + (h > 1 ? T[769] : 0) + (h > 2 ? T[770] : 0); T[256 + tid] += add; }
              if (tid == 0) T[772] = T[768] + T[769] + T[770] + T[771];
              __syncthreads();
              int* SEL = (int*)(ws + WS_MSEL); unsigned short* LIST = (unsigned short*)(ws + WS_MLIST);
              for (int e = bx * (NWAVES * 64) + tid; e < 4 * 16384; e += G * NWAVES * 64) { const int h = e >> 14, t = e & 16383;
                  int v0 = SEL[(size_t)e * 4 + 0], v1 = SEL[(size_t)e * 4 + 1], v2 = SEL[(size_t)e * 4 + 2];
                  if (v0 >= 0) { const int r = T[h * 64 + (v0 >> 16)] + 256 + (v0 & 0xffff); LIST[(size_t)h * 65536 + r] = (unsigned short)t; v0 = r; }
                  if (v1 >= 0) { const int r = T[h * 64 + (v1 >> 16)] + 256 + (v1 & 0xffff); LIST[(size_t)h * 65536 + r] = (unsigned short)t; v1 = r; }
                  if (v2 >= 0) { const int r = T[h * 64 + (v2 >> 16)] + 256 + (v2 & 0xffff); LIST[(size_t)h * 65536 + r] = (unsigned short)t; v2 = r; }
                  SEL[(size_t)e * 4 + 0] = v0; SEL[(size_t)e * 4 + 1] = v1; SEL[(size_t)e * 4 + 2] = v2; SEL[(size_t)e * 4 + 3] = T[h * 64 + (t >> 8)] + (t & 255); } }
            GRID_SYNC();
            { unsigned char* ws = WSPTR(); const int l = step / 3; const int tid = opaque_tid();
              volatile LAS unsigned* MISC = (volatile LAS unsigned*)(ldsl + MISC_OFF);
              volatile LAS int* T = (volatile LAS int*)(ldsl + MISC_OFF + 1024);
              unsigned* qctr = (unsigned*)(ws + WS_CTL) + 64 * (1 + l);
              const attn_body::bf16* QKV = (const attn_body::bf16*)(ws + WS_R1); attn_body::bf16* OBa = (attn_body::bf16*)(ws + WS_OB);
              const int TC = T[772];
              for (;;) {
                  if (tid == 0) MISC[0] = atomicAdd(qctr, 1u);
                  __syncthreads(); const int u = __builtin_amdgcn_readfirstlane((int)MISC[0]); __syncthreads();
                  if (u >= 1024 + TC + 256) break;
                  if (u < 1024) { const int qb = 63 - u / 16, hv = u % 16; const int h = hv >> 2, sub = hv & 3;
                      attn_body::attn_unit<0, 8>(qb, 0, QKV + 1280 + 128 * h + 64 * (sub >> 1), QKV + 1792 + 128 * h + 64 * (sub >> 1), QKV + 2304 + 128 * h + 64 * (sub & 1),
                                                 OBa + 512 + 256 * h + 128 * (sub >> 1) + 64 * (sub & 1), (char*)lds, nullptr, 0.f);
                  } else if (u < 1024 + TC) { const int j = u - 1024; int lo = 0, hi = 255;
                      while (lo < hi) { const int mid = (lo + hi + 1) >> 1; if (T[256 + mid] <= j) lo = mid; else hi = mid - 1; }
                      const int i = __builtin_amdgcn_readfirstlane(lo), h = i >> 6, b = i & 63, c = j - T[256 + i], rb = T[i] + 256 * c; const int n = T[512 + i] - 256 * c;
                      attn_body::bf16* PART = (h < 2 ? (attn_body::bf16*)(ws + WS_W + W_GU1) + (size_t)h * 65536 * 64 : (attn_body::bf16*)(ws + WS_OC) + (size_t)(h - 2) * 65536 * 64) + (size_t)rb * 64;
                      attn_body::attn_unit<3, 0>(b, 4 * b, QKV + 64 * h, QKV + 256 + 64 * h, QKV + 512 + 64 * h, PART, (char*)lds, nullptr, 0.f,
                                                 c == 0 ? nullptr : (const unsigned short*)(ws + WS_MLIST) + (size_t)h * 65536 + rb, n < 256 ? n : 256, (float*)(ws + WS_MSTAT) + (size_t)h * 65536 + rb);
                  } else { const int s = u - 1024 - TC, hq = s & 3, qb = s >> 2; const int t0 = qb == 0 ? 0 : 4 * qb - 2;
                      attn_body::attn_unit<2, 8>(qb, t0, QKV + 768 + 64 * hq, QKV + 1024 + 64 * (hq >> 1), QKV + 1152 + 64 * (hq >> 1), OBa + 256 + 64 * hq, (char*)lds, nullptr, ARGS().in[11][l * 4 + hq] * LOG2E); }
              } }
            GRID_SYNC();
            { unsigned char* ws = WSPTR(); const int tid = opaque_tid(), lane = tid & 63, wave = __builtin_amdgcn_readfirstlane(tid >> 6);
              const int gw = bx * NWAVES + wave, NGW = G * NWAVES; const int h = lane >> 4, j4 = (lane & 15) * 4;
              const bf16* PART = h < 2 ? (const bf16*)(ws + WS_W + W_GU1) + (size_t)h * 65536 * 64 : (const bf16*)(ws + WS_OC) + (size_t)(h - 2) * 65536 * 64;
              const float* ST = (const float*)(ws + WS_MSTAT) + (size_t)h * 65536; const int* SEL = (const int*)(ws + WS_MSEL) + (size_t)h * 16384 * 4; bf16* OB = (bf16*)(ws + WS_OB);
              for (int t0 = gw; t0 < 16384; t0 += 4 * NGW) {
                  typedef int i32x4 __attribute__((ext_vector_type(4)));
                  i32x4 rr[4]; float wl[4][4]; unsigned long long qv[4][4];
#pragma unroll
                  for (int k = 0; k < 4; ++k) rr[k] = *(const i32x4*)(SEL + (size_t)(t0 + k * NGW) * 4);
#pragma unroll
                  for (int k = 0; k < 4; ++k)
#pragma unroll
                      for (int q = 0; q < 4; ++q) { const int r = rr[k][q]; const int rc = r >= 0 ? r : 0; const float w = ST[rc]; wl[k][q] = r >= 0 ? w : -INFINITY; qv[k][q] = *(const unsigned long long*)(PART + (size_t)rc * 64 + j4); }
#pragma unroll
                  for (int k = 0; k < 4; ++k) { const int t = t0 + k * NGW;
                      const float mx = fmaxf(fmaxf(wl[k][0], wl[k][1]), fmaxf(wl[k][2], wl[k][3]));
                      float a0 = 0.f, a1 = 0.f, a2 = 0.f, a3 = 0.f, ws_ = 0.f;
#pragma unroll
                      for (int q = 0; q < 4; ++q) { const float w = __builtin_amdgcn_exp2f(wl[k][q] - mx); ws_ += w; const unsigned lo_ = (unsigned)qv[k][q], hi_ = (unsigned)(qv[k][q] >> 32);
                          a0 += w * __uint_as_float(lo_ << 16); a1 += w * __uint_as_float(lo_ & 0xffff0000u); a2 += w * __uint_as_float(hi_ << 16); a3 += w * __uint_as_float(hi_ & 0xffff0000u); }
                      const float inv = 1.0f / ws_;
                      *(unsigned long long*)(OB + (size_t)t * OPW + 64 * h + j4) = (unsigned long long)pk2(a0 * inv, a1 * inv) | ((unsigned long long)pk2(a2 * inv, a3 * inv) << 32); }
              } }
            { unsigned char* ws = WSPTR(); const int l = step / 3;
              const int tid = opaque_tid(), lane = tid & 63, wave = __builtin_amdgcn_readfirstlane(tid >> 6);
              const int gw = bx * NWAVES + wave, NGW = G * NWAVES;
              const bf16* OB = (const bf16*)(ws + WS_OB); bf16* OC = (bf16*)(ws + WS_OCN);
              const float lam_init = l == 0 ? 0.2f : 0.35550907f;
              const float s1 = wave_sum(ARGS().in[14][l * 64 + lane] * ARGS().in[15][l * 64 + lane]), s2 = wave_sum(ARGS().in[16][l * 64 + lane] * ARGS().in[17][l * 64 + lane]);
              const float lam = expf(s1) - expf(s2) + lam_init;
              const int h = lane >> 4, c0 = (lane & 15) * 8;
              f32x4 sg0 = *(const f32x4*)(ARGS().in[18] + l * 128 + c0), sg1 = *(const f32x4*)(ARGS().in[18] + l * 128 + c0 + 4);
              sg0 = sg0 * (1.0f - lam_init); sg1 = sg1 * (1.0f - lam_init);
              for (int m = gw; m < M; m += NGW) {
                  const bf16* op = OB + (size_t)m * OPW + 512 + 256 * h + c0;
                  f32x4 a0, a1, b0, b1; pg8::unpack8(*(const v4u*)op, a0, a1); pg8::unpack8(*(const v4u*)(op + 128), b0, b1);
                  a0 = a0 - b0 * lam; a1 = a1 - b1 * lam;
                  float ss = (a0[0] * a0[0] + a0[1] * a0[1]) + (a0[2] * a0[2] + a0[3] * a0[3]) + (a1[0] * a1[0] + a1[1] * a1[1]) + (a1[2] * a1[2] + a1[3] * a1[3]);
                  ss += __shfl_xor(ss, 1); ss += __shfl_xor(ss, 2); ss += __shfl_xor(ss, 4); ss += __shfl_xor(ss, 8);
                  const float rn = __builtin_amdgcn_rsqf(ss * (1.0f / 128.0f) + 1e-6f);
                  *(v4u*)(OC + (size_t)m * 512 + 128 * h + c0) = pg8::pack8(a0 * rn * sg0, a1 * rn * sg1);
              } }
            GRID_SYNC();
#define BRANCH_PAIR(WG_OFF, A_EXPR, KB, LDA, WB_OFF, FIRST) \
            { unsigned char* ws = WSPTR(); \
              pg8::Gemm g{(const bf16*)(ws + WS_XB), (const bf16*)(ws + WS_W + W_G + (WG_OFF)), M, 1024, 1024, 1024}; pg8::StaticOrder S; S.init(M, 1024, G, bx); \
              pg8::EpiGate E{(bf16*)(ws + WS_R1), (const float*)(ws + WS_SSQ) + (size_t)step * M * 4}; \
              pg8::gemm_phase<pg8::EpiGate, pg8::StaticOrder, true, true>(ldsl, g, S, E); } \
            { unsigned char* ws = WSPTR(); \
              pg8::Gemm g{(const bf16*)(A_EXPR), (const bf16*)(ws + WS_W + (WB_OFF)), M, 1024, (KB), (LDA)}; pg8::StaticOrder S; S.init(M, 1024, G, bx); \
              pg8::EpiBranch E{(const bf16*)(ws + WS_R1), (bf16*)(ws + WS_R1 + 32 * MiB), (FIRST)}; \
              pg8::gemm_phase<pg8::EpiBranch, pg8::StaticOrder, true, true>(ldsl, g, S, E); }
            BRANCH_PAIR((size_t)0, ws + WS_OB, 256, OPW, W_BA, 1)
            BRANCH_PAIR((size_t)1024 * 1024 * 2, ws + WS_OB + 512, 256, OPW, W_BB, 0)
            BRANCH_PAIR((size_t)2 * 1024 * 1024 * 2, ws + WS_OCN, 512, 512, W_BC, 0)
#undef BRANCH_PAIR
            GRID_SYNC();
            { unsigned char* ws = WSPTR();
              pg8::Gemm g{(const bf16*)(ws + WS_R1 + 32 * MiB), (const bf16*)(ws + WS_W + W_O), M, 1024, 1024, 1024}; pg8::StaticOrder S; S.init(M, 1024, G, bx);
              pg8::EpiResid E{(const float*)ARGS().out, ARGS().out, (bf16*)(ws + WS_XB), (float*)(ws + WS_SSQ) + (size_t)(step + 1) * M * 4, 1.0f};
              pg8::gemm_phase<pg8::EpiResid, pg8::StaticOrder, false, true>(ldsl, g, S, E); }
            GRID_SYNC();
        }
    }
}

#undef G
#undef bx
extern "C" void kernel_launch(void* const* d_in, const int* in_sizes, int n_in, void* d_out, int out_size, void* d_ws, size_t ws_size, hipStream_t stream) {
    static int grid = 0;
    if (grid == 0) {
        if (n_in != 27 || out_size != M * DMODEL || ws_size < WS_END) { fprintf(stderr, "kernel_launch: unexpected shapes (n_in %d out %d ws %zu)\n", n_in, out_size, ws_size); grid = -1; return; }
        int dev = 0, cus = 0, per_cu = 0;
        hipGetDevice(&dev); hipDeviceGetAttribute(&cus, hipDeviceAttributeMultiprocessorCount, dev);
        hipFuncSetAttribute((const void*)mega_fwd, hipFuncAttributeMaxDynamicSharedMemorySize, LDS_BYTES);
        hipOccupancyMaxActiveBlocksPerMultiprocessor(&per_cu, (const void*)mega_fwd, NWAVES * 64, LDS_BYTES);
        if (per_cu < 1) { fprintf(stderr, "kernel_launch: occupancy query says %d blocks per CU\n", per_cu); per_cu = 1; }
        (void)hipGetLastError();
        grid = cus;
    }
    if (grid < 0) return;
    (void)hipMemsetAsync((char*)d_ws + WS_BAR, 0, 16384, stream);
    Args a{};
    for (int i = 0; i < 27; ++i) a.in[i] = (const float*)d_in[i];
    a.out = (float*)d_out; a.ws = (unsigned char*)d_ws;
    void* kargs[] = {&a};
    hipError_t e = hipLaunchCooperativeKernel((const void*)mega_fwd, dim3(grid), dim3(NWAVES * 64), kargs, LDS_BYTES, stream);
    if (e != hipSuccess) fprintf(stderr, "cooperative launch failed: %s (grid %d)\n", hipGetErrorString(e), grid);
}
```

```cpp
#include <hip/hip_runtime.h>
#include <cstdio>
#include <cstdint>
#include <hip/hip_cooperative_groups.h>
namespace pg8 {
#define PG8_LAS __attribute__((address_space(3)))
typedef unsigned short bf16_t;
typedef short bf16x8 __attribute__((ext_vector_type(8)));
typedef float f32x4 __attribute__((ext_vector_type(4)));
typedef unsigned u32x4 __attribute__((ext_vector_type(4)));
constexpr int BM = 256, BK = 64, HALF = 128, HTB = HALF * BK * 2  , STAGE_BYTES = 8 * HTB, NXCD = 8, WGM = 8;

__host__ __device__ __forceinline__ int lds_byte(int r, int c) { const int st = (r >> 4) * 2 + (c >> 5), rr = r & 15, cc = c & 31, ob = rr * 64 + cc * 2; return st * 1024 + (ob ^ (((ob >> 9) & 1) << 5)); }
__host__ __device__ __forceinline__ void stage_rc(int b, int& R, int& C) { const int st = b / 1024, sb = b % 1024, swz = sb ^ (((sb >> 9) & 1) << 5); R = (st >> 1) * 16 + swz / 64; C = (st & 1) * 32 + (swz % 64) / 2; }
__host__ __device__ __forceinline__ int perm32(int rho) { const int n = rho >> 4, i = rho & 15; return 8 * (i >> 2) + 4 * n + (i & 3); }

struct Unit { int pm, pn; };
struct Gemm { const bf16_t* A; const bf16_t* Bt; int M, N, K, lda; };

struct StaticOrder {
    int nM, nN, nwg, G, c;
    __host__ __device__ void init(int M, int N, int G_, int c_) { nM = M / BM; nN = N / BM; nwg = nM * nN; G = G_; c = c_; }
    __host__ __device__ bool next(int i, Unit& u) const {
        const long L = (long)i * G + c; if (L >= nwg) return false;
        int wgid = (int)L; { const int q = nwg / NXCD, r = nwg % NXCD, xcd = wgid % NXCD, off = wgid / NXCD; wgid = (xcd < r ? xcd * (q + 1) : r * (q + 1) + (xcd - r) * q) + off; }
        const int nig = WGM * nN, gid = wgid / nig, fm = gid * WGM, gsz = (nM - fm) < WGM ? (nM - fm) : WGM;
        u.pm = fm + ((wgid % nig) % gsz); u.pn = (wgid % nig) / gsz; return true;
    }
    __device__ __forceinline__ void a_ready(const Unit&) const {}
    __device__ __forceinline__ void done(const Unit&) const {}
};

typedef float f32x2_t __attribute__((ext_vector_type(2))); typedef __bf16 bf16x2_t __attribute__((ext_vector_type(2)));
__device__ __forceinline__ unsigned cvt_pk_bf16(float lo, float hi) { f32x2_t v = {lo, hi}; bf16x2_t b = __builtin_convertvector(v, bf16x2_t); return __builtin_bit_cast(unsigned, b); }
__device__ __forceinline__ u32x4 pack8(const f32x4 a, const f32x4 b) { u32x4 w; w.x = cvt_pk_bf16(a[0], a[1]); w.y = cvt_pk_bf16(a[2], a[3]); w.z = cvt_pk_bf16(b[0], b[1]); w.w = cvt_pk_bf16(b[2], b[3]); return w; }
__device__ __forceinline__ void unpack8(const u32x4 w, f32x4& a, f32x4& b) {
    a[0] = __uint_as_float(w.x << 16); a[1] = __uint_as_float(w.x & 0xffff0000u); a[2] = __uint_as_float(w.y << 16); a[3] = __uint_as_float(w.y & 0xffff0000u);
    b[0] = __uint_as_float(w.z << 16); b[1] = __uint_as_float(w.z & 0xffff0000u); b[2] = __uint_as_float(w.w << 16); b[3] = __uint_as_float(w.w & 0xffff0000u); }
__device__ __forceinline__ float rstd_of(const float* ssq, int row) { const f32x4 a = *(const f32x4*)(ssq + (size_t)row * 4);
    return __builtin_amdgcn_rsqf(((a[0] + a[1]) + (a[2] + a[3])) * (1.0f / 1024.0f) + 1e-6f); }
__device__ __forceinline__ float sigm(float g) { return __builtin_amdgcn_rcpf(1.0f + __builtin_amdgcn_exp2f(-1.4426950408889634f * g)); }

struct EpiFFNUp {
    static constexpr bool PERM = false, AFTER_DRAIN = false;
    bf16_t* O; const float* ssq;
    __device__ __forceinline__ void operator()(const f32x4 (&acc)[2][2][4][2], const Unit& u, int wr, int wc, int fr, int fq) const {
        const int row0 = u.pm * BM + wr * 64 + fr, col0 = u.pn * 128 + wc * 32 + 8 * fq;
#pragma unroll
        for (int ai = 0; ai < 2; ++ai)
#pragma unroll
            for (int m = 0; m < 4; ++m) { if (m == 0) asm volatile("" ::: "memory"); const int row = row0 + ai * HALF + m * 16; const float rs = rstd_of(ssq, row);
                f32x4 o[2];
#pragma unroll
                for (int n = 0; n < 2; ++n) { const f32x4 g = acc[ai][0][m][n] * rs, up = acc[ai][1][m][n] * rs;
#pragma unroll
                    for (int e = 0; e < 4; ++e) o[n][e] = g[e] * sigm(g[e]) * up[e]; }
                *(u32x4*)(O + (size_t)row * 2816 + col0) = pack8(o[0], o[1]); }
    }
};
struct EpiResid {
    static constexpr bool PERM = false, AFTER_DRAIN = true;
    const float* Xin; float* X; bf16_t* XB; float* ssq_out; float scale;
    __device__ __forceinline__ void fused(const f32x4 (&acc)[2][2][4][2], const Unit& u, int wr, int wc, int fr, int fq, PG8_LAS unsigned char* lds, int wid, int lane) const {
        PG8_LAS float* P = (PG8_LAS float*)lds;
        const int row0 = u.pm * BM + wr * 64 + fr, col0 = u.pn * BM + wc * 32 + 8 * fq;
#pragma unroll
        for (int ai = 0; ai < 2; ++ai)
#pragma unroll
            for (int m = 0; m < 4; ++m) { if ((m & 1) == 0) asm volatile("" ::: "memory"); const int row = row0 + ai * HALF + m * 16; float ss = 0.f;
#pragma unroll
                for (int bj = 0; bj < 2; ++bj) { float* p = X + (size_t)row * 1024 + col0 + bj * HALF; const float* pi = Xin + (size_t)row * 1024 + col0 + bj * HALF;
                    f32x4 x0 = *(const f32x4*)pi, x1 = *(const f32x4*)(pi + 4);
                    x0 = x0 + acc[ai][bj][m][0] * scale; x1 = x1 + acc[ai][bj][m][1] * scale;
                    *(f32x4*)p = x0; *(f32x4*)(p + 4) = x1;
                    ss += (x0[0] * x0[0] + x0[1] * x0[1]) + (x0[2] * x0[2] + x0[3] * x0[3]) + (x1[0] * x1[0] + x1[1] * x1[1]) + (x1[2] * x1[2] + x1[3] * x1[3]);
                    *(u32x4*)(XB + (size_t)row * 1024 + col0 + bj * HALF) = pack8(x0, x1); }
                ss += __shfl_xor(ss, 16); ss += __shfl_xor(ss, 32);
                if (fq == 0) P[(ai * HALF + wr * 64 + m * 16 + fr) * 4 + wc] = ss; }
        asm volatile("s_waitcnt lgkmcnt(0)" ::: "memory"); __builtin_amdgcn_s_barrier(); asm volatile("" ::: "memory");
        { const int r = wid * 32 + (lane & 31);
          if (lane < 32) { const f32x4 q = *(const PG8_LAS f32x4*)(P + r * 4); ssq_out[(size_t)(u.pm * BM + r) * 4 + u.pn] = (q[0] + q[1]) + (q[2] + q[3]); } }
        asm volatile("s_waitcnt lgkmcnt(0)" ::: "memory"); __builtin_amdgcn_s_barrier(); asm volatile("" ::: "memory");
    }
};
struct EpiGate {
    static constexpr bool PERM = false, AFTER_DRAIN = false;
    bf16_t* O; const float* ssq;
    __device__ __forceinline__ void operator()(const f32x4 (&acc)[2][2][4][2], const Unit& u, int wr, int wc, int fr, int fq) const {
        const int row0 = u.pm * BM + wr * 64 + fr, col0 = u.pn * BM + wc * 32 + 8 * fq;
#pragma unroll
        for (int ai = 0; ai < 2; ++ai)
#pragma unroll
            for (int m = 0; m < 4; ++m) { if (m == 0) asm volatile("" ::: "memory"); const int row = row0 + ai * HALF + m * 16; const float rs = rstd_of(ssq, row);
#pragma unroll
                for (int bj = 0; bj < 2; ++bj) { f32x4 o[2];
#pragma unroll
                    for (int n = 0; n < 2; ++n)
#pragma unroll
                        for (int e = 0; e < 4; ++e) o[n][e] = sigm(acc[ai][bj][m][n][e] * rs);
                    *(u32x4*)(O + (size_t)row * 1024 + col0 + bj * HALF) = pack8(o[0], o[1]); } }
    }
    __device__ __forceinline__ void fused(const f32x4 (&acc)[2][2][4][2], const Unit& u, int wr, int wc, int fr, int fq, PG8_LAS unsigned char*, int, int) const { (*this)(acc, u, wr, wc, fr, fq); }
};
struct EpiBranch {
    static constexpr bool PERM = false, AFTER_DRAIN = false;
    const bf16_t* G; bf16_t* Mg; int first;
    __device__ __forceinline__ void operator()(const f32x4 (&acc)[2][2][4][2], const Unit& u, int wr, int wc, int fr, int fq) const {
        const int row0 = u.pm * BM + wr * 64 + fr, col0 = u.pn * BM + wc * 32 + 8 * fq;
#pragma unroll
        for (int ai = 0; ai < 2; ++ai)
#pragma unroll
            for (int m = 0; m < 4; ++m) { if ((m & 1) == 0) asm volatile("" ::: "memory"); const int row = row0 + ai * HALF + m * 16;
#pragma unroll
                for (int bj = 0; bj < 2; ++bj) { const size_t off = (size_t)row * 1024 + col0 + bj * HALF;
                    f32x4 g0, g1; unpack8(*(const u32x4*)(G + off), g0, g1);
                    f32x4 o0 = acc[ai][bj][m][0] * g0, o1 = acc[ai][bj][m][1] * g1;
                    if (!first) { f32x4 p0, p1; unpack8(*(const u32x4*)(Mg + off), p0, p1); o0 = o0 + p0; o1 = o1 + p1; }
                    *(u32x4*)(Mg + off) = pack8(o0, o1); } }
    }
    __device__ __forceinline__ void fused(const f32x4 (&acc)[2][2][4][2], const Unit& u, int wr, int wc, int fr, int fq, PG8_LAS unsigned char*, int, int) const { (*this)(acc, u, wr, wc, fr, fq); }
};
struct EpiQKV {
    static constexpr bool PERM = false, AFTER_DRAIN = false;
    bf16_t* O; const float* ssq; const float* cosT; const float* sinT;
    const float *gqa, *gka, *gqb, *gkb, *gqc, *gkc; float* ksum; float c2;
    __device__ __forceinline__ void operator()(const f32x4 (&acc)[2][2][4][2], const Unit& u, int wr, int wc, int fr, int fq) const {
        const int g = 4 * u.pn + wc; const int row0 = u.pm * BM + wr * 64 + fr;
        int kind = 0; const float* gp = gqa; float osc = 1.f; bool dok = false;
        if (g < 4) { kind = 1; gp = gqa; osc = c2; } else if (g < 8) { kind = 1; gp = gka; dok = true; } else if (g < 12) { kind = 0; }
        else if (g < 16) { kind = 1; gp = gqb; osc = c2; } else if (g < 18) { kind = 1; gp = gkb; } else if (g < 20) { kind = 0; }
        else if (g < 28) { kind = 1; gp = gqc; osc = c2; } else if (g < 36) { kind = 1; gp = gkc; } else { kind = 0; }
        bf16_t* ob = O + 64 * g + 8 * fq;
        if (kind == 0) {
#pragma unroll
            for (int ai = 0; ai < 2; ++ai)
#pragma unroll
                for (int m = 0; m < 4; ++m) { if (m == 0) asm volatile("" ::: "memory"); const int row = row0 + ai * HALF + m * 16; const float rs = rstd_of(ssq, row);
#pragma unroll
                    for (int bj = 0; bj < 2; ++bj) *(u32x4*)(ob + (size_t)row * 2816 + 32 * bj) = pack8(acc[ai][bj][m][0] * rs, acc[ai][bj][m][1] * rs); }
        } else {
            f32x4 gv[2][2], cs[2][2];
#pragma unroll
            for (int bj = 0; bj < 2; ++bj)
#pragma unroll
                for (int n = 0; n < 2; ++n) { gv[bj][n] = *(const f32x4*)(gp + 32 * bj + 8 * fq + 4 * n); cs[bj][n] = (f32x4){0.f, 0.f, 0.f, 0.f}; }
#pragma unroll
            for (int ai = 0; ai < 2; ++ai)
#pragma unroll
                for (int m = 0; m < 4; ++m) { if (m == 0) asm volatile("" ::: "memory"); const int row = row0 + ai * HALF + m * 16; const float rs = rstd_of(ssq, row);
                    f32x4 v[2][2]; float ss = 0.f;
#pragma unroll
                    for (int bj = 0; bj < 2; ++bj)
#pragma unroll
                        for (int n = 0; n < 2; ++n) { v[bj][n] = acc[ai][bj][m][n] * rs; const f32x4 q = v[bj][n] * v[bj][n]; ss += (q[0] + q[1]) + (q[2] + q[3]); }
                    ss += __shfl_xor(ss, 16); ss += __shfl_xor(ss, 32);
                    const float rn = __builtin_amdgcn_rsqf(ss * (1.0f / 64.0f) + 1e-6f);
                    f32x4 o[2][2];
#pragma unroll
                    for (int n = 0; n < 2; ++n) { const f32x4 c = *(const f32x4*)(cosT + (size_t)row * 32 + 8 * fq + 4 * n), s = *(const f32x4*)(sinT + (size_t)row * 32 + 8 * fq + 4 * n);
                        const f32x4 y1 = v[0][n] * rn * gv[0][n], y2 = v[1][n] * rn * gv[1][n];
                        o[0][n] = y1 * c - y2 * s; o[1][n] = y2 * c + y1 * s; }
                    if (dok) {
#pragma unroll
                        for (int bj = 0; bj < 2; ++bj)
#pragma unroll
                            for (int n = 0; n < 2; ++n) cs[bj][n] = cs[bj][n] + o[bj][n]; }
#pragma unroll
                    for (int bj = 0; bj < 2; ++bj) *(u32x4*)(ob + (size_t)row * 2816 + 32 * bj) = pack8(o[bj][0] * osc, o[bj][1] * osc); }
            if (dok) {
#pragma unroll
                for (int bj = 0; bj < 2; ++bj)
#pragma unroll
                    for (int n = 0; n < 2; ++n)
#pragma unroll
                        for (int e = 0; e < 4; ++e) { float t = cs[bj][n][e]; t += __shfl_xor(t, 1); t += __shfl_xor(t, 2); t += __shfl_xor(t, 4); t += __shfl_xor(t, 8); cs[bj][n][e] = t; }
                if (fr == 0) { float* kp = ksum + ((size_t)((wr * 4 + (g - 4)) * 64 + u.pm)) * 64 + 8 * fq;
#pragma unroll
                    for (int bj = 0; bj < 2; ++bj)
#pragma unroll
                        for (int n = 0; n < 2; ++n) *(f32x4*)(kp + 32 * bj + 4 * n) = cs[bj][n]; }
            }
        }
    }
};

template <class Epi, class Sched, bool ALIGN_EPI = false, bool SP2 = false>
__device__ __forceinline__ void gemm_phase(PG8_LAS unsigned char* lds, const Gemm g, const Sched& S, const Epi& E) {
    int tid_ = threadIdx.x; asm volatile("" : "+v"(tid_)); const int tid = tid_, wid = __builtin_amdgcn_readfirstlane(tid >> 6), lane = tid & 63, wr = wid >> 2, wc = wid & 3, fr = lane & 15, fq = lane >> 4;
    const int K = g.K, nt = K / BK;
    unsigned voffA[2], voffB[2];
#pragma unroll
    for (int i = 0; i < 2; ++i) { int R, C; stage_rc(tid * 16 + i * 8192, R, C); const int Rb = Epi::PERM ? ((R & ~31) + perm32(R & 31)) : R;
        voffA[i] = (unsigned)(R * g.lda + C) * 2u; voffB[i] = (unsigned)(Rb * K + C) * 2u; }
    const size_t kstep = (size_t)(BK * 2);
    const size_t hstepB = (size_t)HALF * K * 2, hstepA = (size_t)HALF * g.lda * 2;
    const size_t tstepB = 2 * hstepB, tstepA = 2 * hstepA;
    const unsigned ldsw = (unsigned)wid * 1024u;
    const int aoff = lds_byte(wr * 64 + fr, fq * 8), boff = lds_byte(wc * 32 + fr, fq * 8);
#define PG8_SA(b, h) (((b) * 2 + (h)) * HTB)
#define PG8_SB(b, h) ((4 + (b) * 2 + (h)) * HTB)
#define PG8_STAGE(bufoff, gbase, voff) do { _Pragma("unroll") for (int _i = 0; _i < 2; ++_i) \
        __builtin_amdgcn_global_load_lds((const unsigned*)((const char*)(gbase) + (voff)[_i]), (PG8_LAS unsigned*)(lds + (bufoff) + ldsw + _i * 8192), 16, 0, 0); } while (0)
#define PG8_LDA(dst, b, h) do { _Pragma("unroll") for (int m = 0; m < 4; ++m) _Pragma("unroll") for (int k = 0; k < 2; ++k) dst[m][k] = *(const PG8_LAS bf16x8*)(lds + PG8_SA(b, h) + aoff + m * 2048 + k * 1024); } while (0)
#define PG8_LDB(dst, b, h) do { _Pragma("unroll") for (int n = 0; n < 2; ++n) _Pragma("unroll") for (int k = 0; k < 2; ++k) dst[n][k] = *(const PG8_LAS bf16x8*)(lds + PG8_SB(b, h) + boff + n * 2048 + k * 1024); } while (0)
#define PG8_MMA(ai, bj, At, Bt) do { __builtin_amdgcn_s_setprio(1); _Pragma("unroll") for (int m = 0; m < 4; ++m) _Pragma("unroll") for (int n = 0; n < 2; ++n) _Pragma("unroll") for (int k = 0; k < 2; ++k) \
        acc[ai][bj][m][n] = __builtin_amdgcn_mfma_f32_16x16x32_bf16(Bt[n][k], At[m][k], acc[ai][bj][m][n], 0, 0, 0); __builtin_amdgcn_s_setprio(0); } while (0)
#define PG8_WAIT_V(n) asm volatile("s_waitcnt vmcnt(" #n ")" ::: "memory")
#define PG8_WAIT_L(n) asm volatile("s_waitcnt lgkmcnt(" #n ")" ::: "memory")
#define PG8_BAR __builtin_amdgcn_s_barrier()
#define PG8_SCHED __builtin_amdgcn_sched_barrier(0)
    Unit cur, nxt; int ui = 0;
    if (!S.next(0, cur)) return;
    f32x4 acc[2][2][4][2];
#pragma unroll
    for (int a = 0; a < 2; ++a)
#pragma unroll
        for (int b = 0; b < 2; ++b)
#pragma unroll
            for (int m = 0; m < 4; ++m)
#pragma unroll
                for (int n = 0; n < 2; ++n) acc[a][b][m][n] = (f32x4){0.f, 0.f, 0.f, 0.f};
    bf16x8 At[4][2], B0[2][2], B1[2][2];
    const char* cA = (const char*)g.A + (size_t)cur.pm * tstepA; const char* cB = (const char*)g.Bt + (size_t)cur.pn * tstepB;
    S.a_ready(cur);
    if constexpr (SP2) {
        PG8_STAGE(PG8_SB(0, 0), cB, voffB); PG8_STAGE(PG8_SB(0, 1), cB + hstepB, voffB); PG8_STAGE(PG8_SA(0, 0), cA, voffA); PG8_STAGE(PG8_SA(0, 1), cA + hstepA, voffA);
        if (wr == 1) PG8_BAR;
        PG8_WAIT_V(2); PG8_BAR;
        PG8_STAGE(PG8_SB(1, 0), cB + kstep, voffB); PG8_STAGE(PG8_SA(1, 0), cA + kstep, voffA); PG8_STAGE(PG8_SB(1, 1), cB + hstepB + kstep, voffB);
        PG8_WAIT_V(6); PG8_BAR;
    } else {
        PG8_STAGE(PG8_SB(0, 0), cB, voffB); PG8_STAGE(PG8_SA(0, 0), cA, voffA); PG8_STAGE(PG8_SB(0, 1), cB + hstepB, voffB); PG8_STAGE(PG8_SA(0, 1), cA + hstepA, voffA);
        if (wr == 1) PG8_BAR;
        PG8_WAIT_V(4); PG8_BAR;
        PG8_STAGE(PG8_SB(1, 0), cB + kstep, voffB); PG8_STAGE(PG8_SA(1, 0), cA + kstep, voffA); PG8_STAGE(PG8_SB(1, 1), cB + hstepB + kstep, voffB);
        PG8_WAIT_V(6); PG8_BAR;
    }
    for (;;) {
        const bool has_next = S.next(ui + 1, nxt);
        const char* nA = has_next ? (const char*)g.A + (size_t)nxt.pm * tstepA : cA; const char* nB = has_next ? (const char*)g.Bt + (size_t)nxt.pn * tstepB : cB;
        for (int t = 0; t < nt; t += 2) {
            const bool last = (t == nt - 2);
            const char* a1 = cA + (size_t)(t + 1) * kstep;
            const char* a2 = last ? nA : cA + (size_t)(t + 2) * kstep; const char* b2 = last ? nB : cB + (size_t)(t + 2) * kstep;
            const char* a3 = a2 + kstep; const char* b3 = b2 + kstep;
            if (last && has_next) S.a_ready(nxt);
            if constexpr (SP2) {
            PG8_LDB(B0, 0, 0); PG8_LDB(B1, 0, 1); PG8_SCHED; PG8_LDA(At, 0, 0); PG8_STAGE(PG8_SA(1, 1), a1 + hstepA, voffA);
            PG8_WAIT_V(8); PG8_WAIT_L(0); PG8_BAR; PG8_MMA(0, 0, At, B0); PG8_MMA(0, 1, At, B1); PG8_BAR; PG8_SCHED;
            PG8_LDA(At, 0, 1); PG8_STAGE(PG8_SB(0, 0), b2, voffB); PG8_STAGE(PG8_SB(0, 1), b2 + hstepB, voffB); PG8_STAGE(PG8_SA(0, 0), a2, voffA);
            PG8_WAIT_V(8); PG8_WAIT_L(0); PG8_BAR; PG8_MMA(1, 0, At, B0); PG8_MMA(1, 1, At, B1); PG8_BAR; PG8_SCHED;
            PG8_LDB(B0, 1, 0); PG8_LDB(B1, 1, 1); PG8_SCHED; PG8_LDA(At, 1, 0); PG8_STAGE(PG8_SA(0, 1), a2 + hstepA, voffA);
            PG8_WAIT_V(8); PG8_WAIT_L(0); PG8_BAR; PG8_MMA(0, 0, At, B0); PG8_MMA(0, 1, At, B1); PG8_BAR; PG8_SCHED;
            PG8_LDA(At, 1, 1); PG8_STAGE(PG8_SB(1, 0), b3, voffB); PG8_STAGE(PG8_SB(1, 1), b3 + hstepB, voffB); PG8_STAGE(PG8_SA(1, 0), a3, voffA);
            PG8_WAIT_V(8); PG8_WAIT_L(0); PG8_BAR; PG8_MMA(1, 0, At, B0); PG8_MMA(1, 1, At, B1); PG8_BAR; PG8_SCHED;
            } else {
            PG8_LDB(B0, 0, 0); PG8_SCHED; PG8_LDA(At, 0, 0); PG8_STAGE(PG8_SA(1, 1), a1 + hstepA, voffA);
            PG8_WAIT_L(8); PG8_BAR; PG8_WAIT_L(0); PG8_MMA(0, 0, At, B0); PG8_BAR; PG8_SCHED;
            PG8_LDB(B1, 0, 1); PG8_STAGE(PG8_SB(0, 0), b2, voffB);
            PG8_BAR; PG8_WAIT_L(0); PG8_MMA(0, 1, At, B1); PG8_BAR;
            PG8_LDA(At, 0, 1); PG8_STAGE(PG8_SA(0, 0), a2, voffA);
            PG8_BAR; PG8_WAIT_L(0); PG8_MMA(1, 0, At, B0); PG8_BAR; PG8_SCHED;
            PG8_STAGE(PG8_SB(0, 1), b2 + hstepB, voffB);
            PG8_WAIT_V(6); PG8_BAR; PG8_MMA(1, 1, At, B1); PG8_BAR;
            PG8_LDB(B0, 1, 0); PG8_SCHED; PG8_LDA(At, 1, 0); PG8_STAGE(PG8_SA(0, 1), a2 + hstepA, voffA);
            PG8_WAIT_L(8); PG8_BAR; PG8_WAIT_L(0); PG8_MMA(0, 0, At, B0); PG8_BAR; PG8_SCHED;
            PG8_LDB(B1, 1, 1); PG8_STAGE(PG8_SB(1, 0), b3, voffB);
            PG8_BAR; PG8_WAIT_L(0); PG8_MMA(0, 1, At, B1); PG8_BAR;
            PG8_LDA(At, 1, 1); PG8_STAGE(PG8_SA(1, 0), a3, voffA);
            PG8_BAR; PG8_WAIT_L(0); PG8_MMA(1, 0, At, B0); PG8_BAR; PG8_SCHED;
            PG8_STAGE(PG8_SB(1, 1), b3 + hstepB, voffB);
            PG8_WAIT_V(6); PG8_BAR; PG8_MMA(1, 1, At, B1); PG8_BAR;
            }
        }
        if constexpr (ALIGN_EPI) { if (wr == 0) PG8_BAR; }
        if constexpr (!Epi::AFTER_DRAIN) { E(acc, cur, wr, wc, fr, fq); S.done(cur); }
        if (!has_next) break;
#pragma unroll
        for (int a = 0; a < 2; ++a)
#pragma unroll
            for (int b = 0; b < 2; ++b)
#pragma unroll
                for (int m = 0; m < 4; ++m)
#pragma unroll
                    for (int n = 0; n < 2; ++n) acc[a][b][m][n] = (f32x4){0.f, 0.f, 0.f, 0.f};
        cur = nxt; cA = nA; cB = nB; ++ui;
        if constexpr (ALIGN_EPI) { if (wr == 1) PG8_BAR; }
    }
    PG8_WAIT_V(0);
    if constexpr (!ALIGN_EPI) { if (wr == 0) PG8_BAR; }
    PG8_BAR;
    if constexpr (Epi::AFTER_DRAIN) { E.fused(acc, cur, wr, wc, fr, fq, lds, wid, lane); S.done(cur); }
#undef PG8_SA
#undef PG8_SB
#undef PG8_STAGE
#undef PG8_LDA
#undef PG8_LDB
#undef PG8_MMA
#undef PG8_WAIT_V
#undef PG8_WAIT_L
#undef PG8_BAR
#undef PG8_SCHED
}
}

#ifndef PG8_SP2
#define PG8_SP2 true
#endif
#ifndef PG8_ALIGN
#define PG8_ALIGN true
#endif

#include <hip/hip_bf16.h>
#include <cmath>
namespace attn_body {
using bf16=__hip_bfloat16;
using bf16x8=__attribute__((ext_vector_type(8)))short;
using s16x4=__attribute__((ext_vector_type(4)))short;
using f32x16=__attribute__((ext_vector_type(16)))float;
using u32x4=__attribute__((ext_vector_type(4)))unsigned;
constexpr int D=64,DM=2816,OPITCH=1536;
constexpr int NW=8,QBLK=32,QB=QBLK*NW,KVBLK=64;
constexpr int ATTN_PITCH=DM, ATTN_UNIT_ROWS=QB;
__device__ __forceinline__ int crow(int r,int hi){return (r&3)+8*(r>>2)+4*hi;}
#define SBAR() __builtin_amdgcn_sched_barrier(0)
constexpr float NEGV=-1000.0f;
__device__ __forceinline__ void cmask(f32x16&p0,f32x16&p1,int jb,int qrel,int hi){
  const float NEG=NEGV; int kb=64*jb+4*hi;
  #pragma unroll
  for(int r=0;r<16;++r){int kv=kb+(r&3)+8*(r>>2); if(kv>qrel)p0[r]=NEG; if(kv+32>qrel)p1[r]=NEG;}
}
__device__ __forceinline__ void swamask(f32x16&p0,f32x16&p1,int jb,int qrel,int hi){
  const float NEG=NEGV; int kb=64*jb+4*hi;
  #pragma unroll
  for(int r=0;r<16;++r){int kv=kb+(r&3)+8*(r>>2); if(kv>qrel||kv<qrel-127)p0[r]=NEG; if(kv+32>qrel||kv+32<qrel-127)p1[r]=NEG;}
}
__device__ __forceinline__ void mobamask(f32x16&p0,f32x16&p1,unsigned long long sel,int b){
  const float NEG=NEGV; const bool keep=((sel>>b)&1ull)!=0ull;
  #pragma unroll
  for(int r=0;r<16;++r){ p0[r]=keep?p0[r]:NEG; p1[r]=keep?p1[r]:NEG; }
}

constexpr int NSLOT=3, SLOTB=8192;
constexpr int LDS_K=0, LDS_V=NSLOT*SLOTB, LDS_WS=2*NSLOT*SLOTB, LDS_OST=LDS_WS+NW*64*4, LDS_BYTES=LDS_OST+NW*4096;
constexpr float C2=0.125f*1.4426950408889634f;
__device__ __forceinline__ void glds16(const void*gsrc,unsigned lds_dst){unsigned keep;
  asm volatile("s_mov_b32 %0, m0\n\ts_mov_b32 m0, %2\n\ts_nop 0\n\tglobal_load_lds_dwordx4 %1, off\n\ts_mov_b32 m0, %0":"=&s"(keep):"v"(gsrc),"s"(lds_dst):"memory");}
__device__ __forceinline__ float max3f(float a,float b,float c){float r;asm("v_max3_f32 %0, %1, %2, %3":"=v"(r):"v"(a),"v"(b),"v"(c));return r;}
__device__ __forceinline__ float max2f(float a,float b){float r;asm("v_max_f32_e32 %0, %1, %2":"=v"(r):"v"(a),"v"(b));return r;}
__device__ __forceinline__ float fadd_s(float a,float b){float r;asm("v_add_f32_e32 %0, %1, %2":"=v"(r):"v"(a),"v"(b));return r;}
__device__ __forceinline__ float fsub_s(float a,float b){float r;asm("v_sub_f32_e32 %0, %1, %2":"=v"(r):"v"(a),"v"(b));return r;}
typedef float f32x2_t __attribute__((ext_vector_type(2))); typedef __bf16 bf16x2_t __attribute__((ext_vector_type(2)));
__device__ __forceinline__ unsigned cvtpk_s(float lo,float hi){f32x2_t v={lo,hi};bf16x2_t b=__builtin_convertvector(v,bf16x2_t);return __builtin_bit_cast(unsigned,b);}
#define WAIT_BAR(N) asm volatile("s_waitcnt vmcnt(" #N ") lgkmcnt(0)\n\ts_barrier":::"memory")

__device__ __forceinline__ void qkt(f32x16&p0,f32x16&p1,const char*Kslot,const bf16x8*qr,const f32x16&negm,int r32,int hi){
  const char*kb=Kslot+hi*1024+r32*16;
  #pragma unroll
  for(int d0=0;d0<4;++d0){
    const bf16x8 b0=*reinterpret_cast<const bf16x8*>(kb+d0*2048);
    const bf16x8 b1=*reinterpret_cast<const bf16x8*>(kb+d0*2048+512);
    if(d0==0){p0=__builtin_amdgcn_mfma_f32_32x32x16_bf16(b0,qr[0],negm,0,0,0);p1=__builtin_amdgcn_mfma_f32_32x32x16_bf16(b1,qr[0],negm,0,0,0);}
    else{p0=__builtin_amdgcn_mfma_f32_32x32x16_bf16(b0,qr[d0],p0,0,0,0);p1=__builtin_amdgcn_mfma_f32_32x32x16_bf16(b1,qr[d0],p1,0,0,0);}}
}
typedef __attribute__((address_space(3))) const char* lds_cptr;
typedef short v4i16_t __attribute__((ext_vector_type(4)));
__device__ __forceinline__ void kload8(bf16x8*kf,lds_cptr kp){
  kf[0]=*(const __attribute__((address_space(3))) bf16x8*)(kp);      kf[1]=*(const __attribute__((address_space(3))) bf16x8*)(kp+512);
  kf[2]=*(const __attribute__((address_space(3))) bf16x8*)(kp+2048); kf[3]=*(const __attribute__((address_space(3))) bf16x8*)(kp+2560);
  kf[4]=*(const __attribute__((address_space(3))) bf16x8*)(kp+4096); kf[5]=*(const __attribute__((address_space(3))) bf16x8*)(kp+4608);
  kf[6]=*(const __attribute__((address_space(3))) bf16x8*)(kp+6144); kf[7]=*(const __attribute__((address_space(3))) bf16x8*)(kp+6656);
}
__device__ __forceinline__ void kload2(bf16x8*kf,lds_cptr kp,int j){ kf[2*j]=*(const __attribute__((address_space(3))) bf16x8*)(kp+j*2048); kf[2*j+1]=*(const __attribute__((address_space(3))) bf16x8*)(kp+j*2048+512); }
__device__ __forceinline__ s16x4 vtr(lds_cptr p){ return __builtin_bit_cast(s16x4,__builtin_amdgcn_ds_read_tr16_b64_v4i16((__attribute__((address_space(3))) v4i16_t*)p)); }
__device__ __forceinline__ float rowmax(const f32x16&p0,const f32x16&p1){
  float a=max3f(p0[0],p0[1],p1[0]),b=max3f(p0[2],p0[3],p1[1]);a=max3f(a,p1[2],p1[3]);
  #pragma unroll
  for(int r=4;r<16;r+=4){a=max3f(a,p0[r],p0[r+1]);b=max3f(b,p0[r+2],p0[r+3]);a=max3f(a,p1[r],p1[r+1]);b=max3f(b,p1[r+2],p1[r+3]);}
  const float m=max2f(a,b);
  auto rr=__builtin_amdgcn_permlane32_swap(__float_as_uint(m),__float_as_uint(m),false,false);
  return max2f(__uint_as_float(rr[0]),__uint_as_float(rr[1]));
}
__device__ __forceinline__ void pv(f32x16*o,int vb,bf16x8 pa0,bf16x8 pa1,bf16x8 pa2,bf16x8 pa3){
  #pragma unroll
  for(int d0=0;d0<2;++d0){s16x4 lo[4],hi[4];
    #pragma unroll
    for(int ks=0;ks<4;++ks){
      asm volatile("ds_read_b64_tr_b16 %0,%1 offset:%c2":"=&v"(lo[ks]):"v"(vb),"i"(d0*4096+ks*1024):"memory");
      asm volatile("ds_read_b64_tr_b16 %0,%1 offset:%c2":"=&v"(hi[ks]):"v"(vb),"i"(d0*4096+ks*1024+512):"memory");}
    asm volatile("s_waitcnt lgkmcnt(0)":::"memory");SBAR();
    #define PK(k) (bf16x8){lo[k][0],lo[k][1],lo[k][2],lo[k][3],hi[k][0],hi[k][1],hi[k][2],hi[k][3]}
    o[d0]=__builtin_amdgcn_mfma_f32_32x32x16_bf16(pa0,PK(0),o[d0],0,0,0);
    o[d0]=__builtin_amdgcn_mfma_f32_32x32x16_bf16(pa1,PK(1),o[d0],0,0,0);
    o[d0]=__builtin_amdgcn_mfma_f32_32x32x16_bf16(pa2,PK(2),o[d0],0,0,0);
    o[d0]=__builtin_amdgcn_mfma_f32_32x32x16_bf16(pa3,PK(3),o[d0],0,0,0);
    #undef PK
  }
}

#ifndef ATTN_STORE16
#define ATTN_STORE16(p,v) (*(u32x4*)(p)=(v))
#endif
template<int MODE,int THRL> __device__ __forceinline__ void attn_unit(int qb,int t0,const bf16*Q,const bf16*__restrict__ K,const bf16*__restrict__ V,bf16*O,char*shm,const float*ksum,float sinkl2,const unsigned short*list=nullptr,int len=256,float*stat=nullptr){
  int tid_=threadIdx.x; asm volatile("":"+v"(tid_)); const int tid=tid_,lane=tid&63,r32=lane&31,hi=lane>>5; const int wid=__builtin_amdgcn_readfirstlane(tid>>6);
  const int q0=qb*QB;
  const bf16*Qw=Q+(long)(q0+wid*QBLK)*DM;
  const bf16*Kh=K+(long)t0*KVBLK*DM,*Vh=V+(long)t0*KVBLK*DM;
  const unsigned lds0=(unsigned)(uintptr_t)shm;
  float*wsf=(float*)(shm+LDS_WS)+wid*64;
  const bf16*ksrc=Kh+(long)lane*DM+wid*8;
  const bf16*vsrc=Vh+(long)(16*(wid&3)+(lane>>2))*DM+(wid>>2)*32+(lane&3)*8;
  const unsigned kdst=lds0+LDS_K+wid*1024, vdst=lds0+LDS_V+wid*1024;
  #define DMA_K(t,slot) glds16(ksrc+(long)(t)*KVBLK*DM,(unsigned)__builtin_amdgcn_readfirstlane(kdst+(slot)))
  #define DMA_V(t,slot) glds16(vsrc+(long)(t)*KVBLK*DM,(unsigned)__builtin_amdgcn_readfirstlane(vdst+(slot)))
  const int vb0=(int)(lds0+LDS_V)+((lane>>4)&1)*32+(lane&3)*8+(4*hi+((lane&15)>>2))*64;
  const char*Kbase=shm+LDS_K; bf16x8 kf[8];
  const lds_cptr shm3=(lds_cptr)shm; const lds_cptr kp0=shm3+LDS_K+hi*1024+r32*16; const lds_cptr vp0=shm3+LDS_V+((lane>>4)&1)*32+(lane&3)*8+(4*hi+((lane&15)>>2))*64;
  const int NT=(q0+QB)/KVBLK-t0;
  bf16x8 qr[4]; unsigned long long sel=0ull;
  const bf16*Qrow=Qw+(long)r32*DM;
  if(MODE==3){ const int p_=wid*QBLK+r32; const long trow_=list?(long)list[p_<len?p_:len-1]:(long)(q0+p_); Qrow=Q+trow_*DM; }
  if(MODE==1){
    #pragma unroll
    for(int d0=0;d0<4;++d0)qr[d0]=*reinterpret_cast<const bf16x8*>(&Qrow[d0*16+hi*8]);
    float*km=(float*)(shm+86016);
    #pragma unroll
    for(int i=0;i<8;++i){const int e=tid+512*i; km[e]=(ksum[e]+ksum[e+4*64*64])*(1.0f/256.0f);}
    asm volatile("s_waitcnt vmcnt(0) lgkmcnt(0)\n\ts_barrier":::"memory");
    float qf[32];
    #pragma unroll
    for(int d0=0;d0<4;++d0)
      #pragma unroll
      for(int j=0;j<8;++j)qf[d0*8+j]=__uint_as_float(((unsigned)(unsigned short)qr[d0][j])<<16);
    float t1=-INFINITY,t2=-INFINITY,t3=-INFINITY; int i1=-1,i2=-1,i3=-1;
    for(int b=0;b<qb;++b){
      const float*kr=km+b*64+hi*8; float g=0.f;
      #pragma unroll
      for(int d0=0;d0<4;++d0)
        #pragma unroll
        for(int j=0;j<8;++j)g+=qf[d0*8+j]*kr[d0*16+j];
      g+=__shfl_xor(g,32);
      if(g>t3){ if(g>t2){ t3=t2;i3=i2; if(g>t1){t2=t1;i2=i1;t1=g;i1=b;} else {t2=g;i2=b;} } else {t3=g;i3=b;} }
    }
    if(i1>=0)sel|=1ull<<i1; if(i2>=0)sel|=1ull<<i2; if(i3>=0)sel|=1ull<<i3;
  }
  DMA_K(0,0);DMA_V(0,0);DMA_K(1,SLOTB);
  if(MODE!=1){
    #pragma unroll
    for(int d0=0;d0<4;++d0)qr[d0]=*reinterpret_cast<const bf16x8*>(&Qrow[d0*16+hi*8]);
  }
  float mhat=0.f,l_reg=0.f;f32x16 o[2];o[0]=f32x16{};o[1]=f32x16{};f32x16 negm=f32x16{};asm volatile("":"+v"(negm));
  const int qrel=wid*QBLK+r32;
  #define CMASK(P0,P1,t) do{int jb_=(t)-(NT-4); if(MODE==3){ if(!list&&jb_>=0)cmask(P0,P1,jb_,qrel,hi); } else if(MODE==2){swamask(P0,P1,jb_,qrel,hi);} else if(jb_>=0){cmask(P0,P1,jb_,qrel,hi);} else if(MODE==1){mobamask(P0,P1,sel,(t)>>2);} }while(0)
  bool resc=false;
  #define START(P0,P1) do{ const float rm=rowmax(P0,P1); resc=false; \
    { const float dl=rm; mhat=fadd_s(mhat,dl); \
      _Pragma("unroll") for(int r=0;r<16;++r){P0[r]=fsub_s(P0[r],dl);P1[r]=fsub_s(P1[r],dl);} \
      _Pragma("unroll") for(int r=0;r<16;++r)negm[r]=-mhat; asm volatile("":"+v"(negm)); } \
    _Pragma("unroll") for(int r=0;r<16;++r)P0[r]=__builtin_amdgcn_exp2f(P0[r]); }while(0)
  #define RESC() do{ if(resc){ asm volatile("s_waitcnt lgkmcnt(0)":::"memory"); \
      _Pragma("unroll") for(int d_=0;d_<2;++d_) _Pragma("unroll") for(int r=0;r<16;++r)o[d_][r]*=wsf[crow(r,hi)]; } }while(0)
  f32x16 pA0,pA1,pB0,pB1;
  int sl_prev=0,sl_cur=0,sl_next=SLOTB;
  #define ROT() do{sl_prev=sl_cur;sl_cur=sl_next;sl_next=(sl_next==(NSLOT-1)*SLOTB)?0:sl_next+SLOTB;}while(0)
  DMA_K(2,2*SLOTB);
  WAIT_BAR(3);
  qkt(pA0,pA1,Kbase,qr,negm,r32,hi);asm volatile("s_nop 15\n\ts_nop 7":"+v"(pA0),"+v"(pA1));CMASK(pA0,pA1,0);
  START(pA0,pA1);
  _Pragma("unroll") for(int r=0;r<16;++r)pA1[r]=__builtin_amdgcn_exp2f(pA1[r]);
  WAIT_BAR(0);
  DMA_K(3,0);DMA_V(1,SLOTB);
  ROT();
  kload8(kf,kp0+sl_cur);
  WAIT_BAR(2);
  s16x4 vlo[8],vhi[8]; u32x4 pw0,pw1,pw2,pw3;
  #define PKW(P,B) cvtpk_s(P[B],P[B+1])
  #define PAF(k) __builtin_bit_cast(bf16x8,pw##k)
  #define VFR(i) (bf16x8){vlo[i][0],vlo[i][1],vlo[i][2],vlo[i][3],vhi[i][0],vhi[i][1],vhi[i][2],vhi[i][3]}
  #define PIN(x) asm volatile("":"+v"(x))
  #define MX3(a,b,c) __builtin_fmaxf(__builtin_fmaxf((a),(b)),(c))
  #define GAPA(MF,A0,A1,A2,A3,W0,W1,PW) do{ MF; sacc+=A0; sacc+=A1; sacc+=A2; sacc+=A3; PIN(sacc); W0; W1; PIN(PW); SBAR(); }while(0)
  #define EX(v) __builtin_amdgcn_exp2f(v)
  #define GAPB(MF,X,B) do{ MF; X[B]=EX(X[B]); X[B+1]=EX(X[B+1]); X[B+2]=EX(X[B+2]); X[B+3]=EX(X[B+3]); PIN(X); SBAR(); }while(0)
  #define VRD(i) do{ vlo[i]=vtr(vp_+(((i)>>2)*4096+((i)&3)*1024)); vhi[i]=vtr(vp_+(((i)>>2)*4096+((i)&3)*1024+512)); }while(0)
  #define KRD(G,j) do{ if(G){ kload2(kf,kp0+sl_next,j); SBAR(); } }while(0)
  #define STEP(C0,C1,P0,P1,t,GK,GV,GL) do{ SBAR(); \
    const lds_cptr vp_=vp0+sl_prev; \
    VRD(0); SBAR(); float sacc=(P0[0]+P0[1]); \
    GAPA(C0=__builtin_amdgcn_mfma_f32_32x32x16_bf16(kf[0],qr[0],negm,0,0,0), P0[2],P0[3],P0[4],P0[5],     pw0[0]=PKW(P0,0), pw0[1]=PKW(P0,2), pw0); \
    VRD(4); SBAR(); GAPA(C1=__builtin_amdgcn_mfma_f32_32x32x16_bf16(kf[1],qr[0],negm,0,0,0), P0[6],P0[7],P0[8],P0[9],     pw0[2]=PKW(P0,4), pw0[3]=PKW(P0,6), pw0); \
    VRD(1); SBAR(); GAPA(C0=__builtin_amdgcn_mfma_f32_32x32x16_bf16(kf[2],qr[1],C0,0,0,0),   P0[10],P0[11],P0[12],P0[13], pw1[0]=PKW(P0,8), pw1[1]=PKW(P0,10), pw1); \
    VRD(5); SBAR(); GAPA(C1=__builtin_amdgcn_mfma_f32_32x32x16_bf16(kf[3],qr[1],C1,0,0,0),   P0[14],P0[15],P1[0],P1[1],   pw1[2]=PKW(P0,12),pw1[3]=PKW(P0,14), pw1); \
    VRD(2); SBAR(); GAPA(C0=__builtin_amdgcn_mfma_f32_32x32x16_bf16(kf[4],qr[2],C0,0,0,0),   P1[2],P1[3],P1[4],P1[5],     pw2[0]=PKW(P1,0), pw2[1]=PKW(P1,2), pw2); \
    VRD(6); SBAR(); GAPA(C1=__builtin_amdgcn_mfma_f32_32x32x16_bf16(kf[5],qr[2],C1,0,0,0),   P1[6],P1[7],P1[8],P1[9],     pw2[2]=PKW(P1,4), pw2[3]=PKW(P1,6), pw2); \
    VRD(3); SBAR(); GAPA(C0=__builtin_amdgcn_mfma_f32_32x32x16_bf16(kf[6],qr[3],C0,0,0,0),   P1[10],P1[11],P1[12],P1[13], pw3[0]=PKW(P1,8), pw3[1]=PKW(P1,10), pw3); \
    VRD(7); SBAR(); GAPA(C1=__builtin_amdgcn_mfma_f32_32x32x16_bf16(kf[7],qr[3],C1,0,0,0),   P1[14],P1[15],0.f,0.f,       pw3[2]=PKW(P1,12),pw3[3]=PKW(P1,14), pw3); \
    l_reg+=sacc; \
    if(GK){DMA_K((t)+3,sl_cur);} if(GV){DMA_V((t)+1,sl_next);} \
    CMASK(C0,C1,t); \
    { float a=MX3(C0[0],C0[1],C1[0]),b=MX3(C0[2],C0[3],C1[1]); a=MX3(a,C1[2],C1[3]); \
      _Pragma("unroll") for(int r=4;r<16;r+=4){a=MX3(a,C0[r],C0[r+1]);b=MX3(b,C0[r+2],C0[r+3]);a=MX3(a,C1[r],C1[r+1]);b=MX3(b,C1[r+2],C1[r+3]);} \
      float rm=__builtin_fmaxf(a,b); { auto rr=__builtin_amdgcn_permlane32_swap(__float_as_uint(rm),__float_as_uint(rm),false,false); rm=__builtin_fmaxf(__uint_as_float(rr[0]),__uint_as_float(rr[1])); } \
      resc=false; \
      if(__builtin_expect(__any(rm>(float)THRL),0)){ const float dl=__builtin_fmaxf(rm,0.f); mhat+=dl; \
        _Pragma("unroll") for(int r=0;r<16;++r){C0[r]-=dl;C1[r]-=dl;} \
        _Pragma("unroll") for(int r=0;r<16;++r)negm[r]=-mhat; asm volatile("":"+v"(negm)); \
        const float f=__builtin_amdgcn_exp2f(-dl); l_reg*=f; if(hi==0)wsf[r32]=f; resc=true; } } \
    SBAR(); \
    GAPB(o[0]=__builtin_amdgcn_mfma_f32_32x32x16_bf16(PAF(0),VFR(0),o[0],0,0,0), C0,0); \
    GAPB(o[1]=__builtin_amdgcn_mfma_f32_32x32x16_bf16(PAF(0),VFR(4),o[1],0,0,0), C0,4); \
    KRD(GL,0); GAPB(o[0]=__builtin_amdgcn_mfma_f32_32x32x16_bf16(PAF(1),VFR(1),o[0],0,0,0), C0,8); \
    KRD(GL,1); GAPB(o[1]=__builtin_amdgcn_mfma_f32_32x32x16_bf16(PAF(1),VFR(5),o[1],0,0,0), C0,12); \
    KRD(GL,2); GAPB(o[0]=__builtin_amdgcn_mfma_f32_32x32x16_bf16(PAF(2),VFR(2),o[0],0,0,0), C1,0); \
    KRD(GL,3); GAPB(o[1]=__builtin_amdgcn_mfma_f32_32x32x16_bf16(PAF(2),VFR(6),o[1],0,0,0), C1,4); \
    GAPB(o[0]=__builtin_amdgcn_mfma_f32_32x32x16_bf16(PAF(3),VFR(3),o[0],0,0,0), C1,8); \
    GAPB(o[1]=__builtin_amdgcn_mfma_f32_32x32x16_bf16(PAF(3),VFR(7),o[1],0,0,0), C1,12); \
    }while(0)
  int t=1;
  #undef CMASK
  #define CMASK(P0,P1,t) do{ if(MODE==1){mobamask(P0,P1,sel,(t)>>2);} }while(0)
  for(;t+5<NT;t+=2){
    STEP(pB0,pB1,pA0,pA1,t,true,true,true);     WAIT_BAR(2); RESC(); ROT();
    STEP(pA0,pA1,pB0,pB1,t+1,true,true,true);   WAIT_BAR(2); RESC(); ROT();
  }
  #undef CMASK
  #define CMASK(P0,P1,t) do{int jb_=(t)-(NT-4); if(MODE==3){ if(!list&&jb_>=0)cmask(P0,P1,jb_,qrel,hi); } else if(MODE==2){swamask(P0,P1,jb_,qrel,hi);} else if(jb_>=0){cmask(P0,P1,jb_,qrel,hi);} else if(MODE==1){mobamask(P0,P1,sel,(t)>>2);} }while(0)
  #define ENDW(tt) do{ if((tt)+3<NT){WAIT_BAR(2);} else if((tt)+2<NT){WAIT_BAR(1);} else {WAIT_BAR(0);} }while(0)
  for(;t+1<NT;t+=2){
    STEP(pB0,pB1,pA0,pA1,t,(t+3<NT),(t+1<NT),(t+1<NT));       ENDW(t);   RESC(); ROT();
    STEP(pA0,pA1,pB0,pB1,t+1,(t+4<NT),(t+2<NT),(t+2<NT));     ENDW(t+1); RESC(); ROT();
  }
  STEP(pB0,pB1,pA0,pA1,NT-1,false,false,false); RESC();
  { float sacc=pB0[0]+pB0[1]; _Pragma("unroll") for(int r=2;r<16;++r)sacc+=pB0[r]; _Pragma("unroll") for(int r=0;r<16;++r)sacc+=pB1[r]; l_reg+=sacc;
    pw0=(u32x4){PKW(pB0,0),PKW(pB0,2),PKW(pB0,4),PKW(pB0,6)};pw1=(u32x4){PKW(pB0,8),PKW(pB0,10),PKW(pB0,12),PKW(pB0,14)};pw2=(u32x4){PKW(pB1,0),PKW(pB1,2),PKW(pB1,4),PKW(pB1,6)};pw3=(u32x4){PKW(pB1,8),PKW(pB1,10),PKW(pB1,12),PKW(pB1,14)};
    SBAR(); pv(o,vb0+sl_cur,PAF(0),PAF(1),PAF(2),PAF(3)); }
  #undef PKW
  #undef PAF
  #undef VFR
  #undef PIN
  #undef MX3
  #undef GAPA
  #undef GAPB
  #undef EX
  #undef VRD
  #undef KRD
  #undef STEP
  #undef ENDW
  {auto rr=__builtin_amdgcn_permlane32_swap(__float_as_uint(l_reg),__float_as_uint(l_reg),false,false);l_reg=__uint_as_float(rr[0])+__uint_as_float(rr[1]);}
  if(MODE==2)l_reg+=__builtin_amdgcn_exp2f(sinkl2-mhat);
  if(MODE==3){ const int p_=wid*QBLK+r32; if(hi==0&&p_<len)stat[p_]=mhat+__builtin_amdgcn_logf(l_reg); }
  if(hi==0)wsf[32+r32]=l_reg;asm volatile("s_waitcnt lgkmcnt(0)":::"memory");
  float rli[16];
  #pragma unroll
  for(int r=0;r<16;++r)rli[r]=__builtin_amdgcn_rcpf(wsf[32+crow(r,hi)]);
  constexpr int OP_=(MODE==3)?64:OPITCH; bf16*Ow=(MODE==3)?O+(long)(wid*QBLK)*OP_:O+(long)(q0+wid*QBLK)*OP_;
  { bf16*stg=(bf16*)(shm+LDS_OST)+wid*2048;
    #pragma unroll
    for(int r=0;r<16;++r){const int orow=crow(r,hi);
      #pragma unroll
      for(int d0=0;d0<2;++d0)stg[orow*64+d0*32+r32]=__float2bfloat16(o[d0][r]*rli[r]);}
    asm volatile("s_waitcnt lgkmcnt(0)":::"memory");
    #pragma unroll
    for(int i=0;i<4;++i){const int row=i*8+(lane>>3),ch=lane&7; const u32x4 v=*(const u32x4*)(stg+row*64+ch*8); if(MODE!=3||wid*QBLK+row<len)ATTN_STORE16(Ow+(long)row*OP_+ch*8,v);} }
  asm volatile("s_waitcnt lgkmcnt(0)\n\ts_barrier":::"memory");
  #undef DMA_K
  #undef DMA_V
  #undef CMASK
  #undef START
  #undef RESC
  #undef ROT
}

__device__ __forceinline__ void moba_gate(int qb,const bf16*Q,char*shm,const float*ksum,unsigned*cnt,int*seltmp){
  typedef __attribute__((address_space(3))) int* lds_iptr;
  int tid_=threadIdx.x; asm volatile("":"+v"(tid_)); const int tid=tid_,lane=tid&63,r32=lane&31,hi=lane>>5; const int wid=__builtin_amdgcn_readfirstlane(tid>>6);
  const int t=qb*QB+wid*QBLK+r32; const bf16*Qrow=Q+(long)t*DM; bf16x8 qr[4];
  #pragma unroll
  for(int d0=0;d0<4;++d0)qr[d0]=*reinterpret_cast<const bf16x8*>(&Qrow[d0*16+hi*8]);
  float*km=(float*)(shm+86016);
  const lds_iptr hist=(lds_iptr)((lds_cptr)shm+102400);
  #pragma unroll
  for(int i=0;i<8;++i){const int e=tid+512*i; km[e]=(ksum[e]+ksum[e+4*64*64])*(1.0f/256.0f);}
  if(tid<64)hist[tid]=0;
  asm volatile("s_waitcnt vmcnt(0) lgkmcnt(0)\n\ts_barrier":::"memory");
  float qf[32];
  #pragma unroll
  for(int d0=0;d0<4;++d0)
    #pragma unroll
    for(int j=0;j<8;++j)qf[d0*8+j]=__uint_as_float(((unsigned)(unsigned short)qr[d0][j])<<16);
  float t1=-INFINITY,t2=-INFINITY,t3=-INFINITY; int i1=-1,i2=-1,i3=-1;
  for(int b=0;b<qb;++b){
    const float*kr=km+b*64+hi*8; float g=0.f;
    #pragma unroll
    for(int d0=0;d0<4;++d0)
      #pragma unroll
      for(int j=0;j<8;++j)g+=qf[d0*8+j]*kr[d0*16+j];
    g+=__shfl_xor(g,32);
    if(g>t3){ if(g>t2){ t3=t2;i3=i2; if(g>t1){t2=t1;i2=i1;t1=g;i1=b;} else {t2=g;i2=b;} } else {t3=g;i3=b;} }
  }
  int k1=0,k2=0,k3=0;
  if(hi==0){ if(i1>=0)k1=__hip_atomic_fetch_add(hist+i1,1,__ATOMIC_RELAXED,__HIP_MEMORY_SCOPE_WORKGROUP);
             if(i2>=0)k2=__hip_atomic_fetch_add(hist+i2,1,__ATOMIC_RELAXED,__HIP_MEMORY_SCOPE_WORKGROUP);
             if(i3>=0)k3=__hip_atomic_fetch_add(hist+i3,1,__ATOMIC_RELAXED,__HIP_MEMORY_SCOPE_WORKGROUP); }
  asm volatile("s_waitcnt vmcnt(0) lgkmcnt(0)\n\ts_barrier":::"memory");
  if(tid<64){ const int n=hist[tid]; hist[64+tid]=n>0?(int)atomicAdd(cnt+tid,(unsigned)n):0; }
  asm volatile("s_waitcnt vmcnt(0) lgkmcnt(0)\n\ts_barrier":::"memory");
  if(hi==0){ int v1=-1,v2=-1,v3=-1;
    if(i1>=0)v1=(i1<<16)|(hist[64+i1]+k1);
    if(i2>=0)v2=(i2<<16)|(hist[64+i2]+k2);
    if(i3>=0)v3=(i3<<16)|(hist[64+i3]+k3);
    seltmp[(long)t*4+0]=v1; seltmp[(long)t*4+1]=v2; seltmp[(long)t*4+2]=v3; }
  asm volatile("s_waitcnt vmcnt(0) lgkmcnt(0)\n\ts_barrier":::"memory");
}
constexpr int ATTN_LDS_BYTES=LDS_BYTES;
#undef SBAR
#undef WAIT_BAR
}

namespace cg = cooperative_groups;
constexpr int NWAVES = 8;
constexpr int M = 16384, DMODEL = 1024, DFF = 2816, QKVW = 2816, OPW = 1536;
constexpr size_t MiB = 1u << 20;
constexpr size_t WS_BAR = 512 * 1024;
constexpr size_t WS_CTL = 0;
constexpr size_t WS_SSQ = 244 * MiB;
constexpr size_t WS_KSUM = 2 * MiB;
constexpr size_t WS_COS = 3 * MiB, WS_SIN = 5 * MiB;
constexpr size_t WS_W = 8 * MiB;
constexpr size_t W_GU1 = 0, W_D1 = W_GU1 + (size_t)5632 * 1024 * 2, W_QKV = W_D1 + (size_t)1024 * 2816 * 2, W_G = W_QKV + (size_t)2816 * 1024 * 2,
                 W_BA = W_G + (size_t)3 * 1024 * 1024 * 2, W_BB = W_BA + (size_t)1024 * 256 * 2, W_BC = W_BB + (size_t)1024 * 256 * 2, W_O = W_BC + (size_t)1024 * 512 * 2,
                 W_GU2 = W_O + (size_t)1024 * 1024 * 2, W_D2 = W_GU2 + (size_t)5632 * 1024 * 2, W_END = W_D2 + (size_t)1024 * 2816 * 2;
static_assert(W_END <= 52 * MiB, "weights");
constexpr size_t WS_XB = 60 * MiB;
constexpr size_t WS_R1 = 92 * MiB;
constexpr size_t WS_OB = 180 * MiB;
constexpr size_t WS_OC = 228 * MiB;
constexpr size_t WS_OCN = WS_R1 + 64 * MiB;
constexpr size_t WS_MSTAT = 252 * MiB;
constexpr size_t WS_MSEL = 253 * MiB;
constexpr size_t WS_MLIST = 254 * MiB;
constexpr size_t WS_END = 255 * MiB;
constexpr int RING_BYTES = 131072, MISC_OFF = RING_BYTES, LDS_BYTES = 147456;
constexpr int KM_OFF = 86016;
static_assert(attn_body::ATTN_LDS_BYTES <= KM_OFF && KM_OFF + 16384 <= RING_BYTES, "lds map");

#define LAS __attribute__((address_space(3)))
typedef unsigned short bf16;
typedef unsigned v4u __attribute__((ext_vector_type(4)));
typedef float f32x4 __attribute__((ext_vector_type(4)));
#define LDS_WAIT() asm volatile("s_waitcnt lgkmcnt(0)" ::: "memory")
__device__ __forceinline__ unsigned f2bf(float f) { unsigned u = __builtin_bit_cast(unsigned, f); return (u + 0x7fffu + ((u >> 16) & 1u)) >> 16; }
__device__ __forceinline__ unsigned pk2(float lo, float hi) { return f2bf(lo) | (f2bf(hi) << 16); }
__device__ __forceinline__ float wave_sum(float v) {
#pragma unroll
    for (int o = 1; o < 64; o <<= 1) v += __shfl_xor(v, o);
    return v;
}

__device__ __forceinline__ void conv_item(const float* W, int ldw, int col0, int ncols, int K, const float* gain, int mode, int bsel, bf16* WT, LAS float* scr, int item, int lane) {
    const int nblk = ncols / 32, kb = item / nblk, nb = item % nblk, k0 = 64 * kb, n0 = col0 + 32 * nb;
    { float wv[32]; const float* wp = W + (size_t)(k0 + (lane >> 5)) * ldw + n0 + (lane & 31);
#pragma unroll
      for (int i = 0; i < 32; ++i) wv[i] = __builtin_nontemporal_load(&wp[(size_t)(2 * i) * ldw]);
      if (gain) {
#pragma unroll
          for (int i = 0; i < 32; ++i) wv[i] *= gain[k0 + 2 * i + (lane >> 5)]; }
#pragma unroll
      for (int i = 0; i < 32; ++i) scr[(2 * i + (lane >> 5)) * 33 + (lane & 31)] = wv[i]; }
    LDS_WAIT(); asm volatile("" ::: "memory");
    int pbase;
    if (mode == 0) pbase = 32 * nb; else if (mode == 1) pbase = 256 * (nb >> 3) + 128 * (nb & 1) + 32 * ((nb >> 1) & 3); else pbase = 256 * (nb >> 2) + 128 * bsel + 32 * (nb & 3);
    const int c = lane & 7;
#pragma unroll
    for (int j = 0; j < 4; ++j) { const int n = (lane >> 3) + 8 * j; const LAS float* s = scr + (8 * c) * 33 + n;
        const int prow = pbase + 16 * ((n >> 2) & 1) + 4 * (n >> 3) + (n & 3);
        v4u o; o.x = pk2(s[0 * 33], s[1 * 33]); o.y = pk2(s[2 * 33], s[3 * 33]); o.z = pk2(s[4 * 33], s[5 * 33]); o.w = pk2(s[6 * 33], s[7 * 33]);
        *(v4u*)(WT + (size_t)prow * K + k0 + 8 * c) = o; }
    LDS_WAIT(); asm volatile("" ::: "memory");
}

struct Args { const float* in[27]; float* out; unsigned char* ws; };

template <class ArgsRef> __device__ __forceinline__ void conv_layer(const ArgsRef& a, int l, unsigned char* wsb, LAS float* scr, int gw, int NGW, int lane, int mi_lo, int mi_hi) {
    bf16* WB = (bf16*)(wsb + WS_W);
#pragma nounroll
    for (int mi = mi_lo; mi < mi_hi; ++mi) {
        const float* W; int ldw, col0 = 0, ncols, K, mode = 0, bsel = 0; const float* gain = nullptr; size_t dst;
        switch (mi) {
            case 0: W = a.in[2] + (size_t)l * 1024 * 2816; ldw = 2816; ncols = 2816; K = 1024; gain = a.in[1] + l * 1024; mode = 2; bsel = 0; dst = W_GU1; break;
            case 1: W = a.in[3] + (size_t)l * 1024 * 2816; ldw = 2816; ncols = 2816; K = 1024; gain = a.in[1] + l * 1024; mode = 2; bsel = 1; dst = W_GU1; break;
            case 2: W = a.in[4] + (size_t)l * 2816 * 1024; ldw = 1024; ncols = 1024; K = 2816; dst = W_D1; break;
            case 3: W = a.in[6] + (size_t)l * 1024 * 5888; ldw = 5888; ncols = 2816; K = 1024; gain = a.in[5] + l * 1024; mode = 1; dst = W_QKV; break;
            case 4: W = a.in[6] + (size_t)l * 1024 * 5888; ldw = 5888; col0 = 2816; ncols = 1024; K = 1024; gain = a.in[5] + l * 1024; dst = W_G; break;
            case 5: W = a.in[6] + (size_t)l * 1024 * 5888; ldw = 5888; col0 = 3840; ncols = 1024; K = 1024; gain = a.in[5] + l * 1024; dst = W_G + (size_t)1024 * 1024 * 2; break;
            case 6: W = a.in[6] + (size_t)l * 1024 * 5888; ldw = 5888; col0 = 4864; ncols = 1024; K = 1024; gain = a.in[5] + l * 1024; dst = W_G + (size_t)2 * 1024 * 1024 * 2; break;
            case 7: W = a.in[19] + (size_t)l * 256 * 1024; ldw = 1024; ncols = 1024; K = 256; dst = W_BA; break;
            case 8: W = a.in[20] + (size_t)l * 256 * 1024; ldw = 1024; ncols = 1024; K = 256; dst = W_BB; break;
            case 9: W = a.in[21] + (size_t)l * 512 * 1024; ldw = 1024; ncols = 1024; K = 512; dst = W_BC; break;
            case 10: W = a.in[22] + (size_t)l * 1024 * 1024; ldw = 1024; ncols = 1024; K = 1024; dst = W_O; break;
            case 11: W = a.in[26] + (size_t)l * 2816 * 1024; ldw = 1024; ncols = 1024; K = 2816; dst = W_D2; break;
            case 12: W = a.in[24] + (size_t)l * 1024 * 2816; ldw = 2816; ncols = 2816; K = 1024; gain = a.in[23] + l * 1024; mode = 2; bsel = 0; dst = W_GU2; break;
            default: W = a.in[25] + (size_t)l * 1024 * 2816; ldw = 2816; ncols = 2816; K = 1024; gain = a.in[23] + l * 1024; mode = 2; bsel = 1; dst = W_GU2; break;
        }
        const int nitems = (K / 64) * (ncols / 32);
        bf16* WT = (bf16*)((unsigned char*)WB + dst);
        for (int it = gw; it < nitems; it += NGW) conv_item(W, ldw, col0, ncols, K, gain, mode, bsel, WT, scr, it, lane);
    }
}

constexpr int N_HEAVY = 64 * 20, N_UNITS = N_HEAVY + 256;
constexpr float LOG2E = 1.4426950408889634f;

#define XB_TMO      128
#define XB_XCNT(j)  (256  + 64 * (j))
#define XB_XSUB(j)  (1280 + 64 * (j))
#define XB_XGEN(j)  (2304 + 64 * (j))
#define XB_TOP      3328
#define XB_TOPGEN   3392
#define XCD_BAR_WORDS 3456
#define XB_SPIN_CAP (1u << 18)

__device__ __forceinline__ unsigned xb_ld(unsigned* p)              { return __hip_atomic_load(p, __ATOMIC_RELAXED, __HIP_MEMORY_SCOPE_AGENT); }
__device__ __forceinline__ unsigned xb_add(unsigned* p, unsigned v) { return __hip_atomic_fetch_add(p, v, __ATOMIC_RELAXED, __HIP_MEMORY_SCOPE_AGENT); }
__device__ __forceinline__ unsigned xb_xcc_id() { return (unsigned)__builtin_amdgcn_s_getreg((3 << 11) | 20) & 0xFu; }
#define XB_SPIN(cond, bar) do { unsigned _sp = 0; while (cond) { __builtin_amdgcn_s_sleep(1); \
    if ((++_sp & 255u) == 0u) { if (xb_ld(&(bar)[XB_TMO])) break; if (_sp > XB_SPIN_CAP) { atomicAdd(&(bar)[XB_TMO], 1u); break; } } } } while (0)

struct XcdBarrier {
    unsigned* bar; unsigned x;
    volatile LAS unsigned* st;
};

__device__ __forceinline__ XcdBarrier xcd_barrier_post(unsigned* bar, volatile LAS unsigned* st) {
    XcdBarrier b; b.bar = bar; b.x = xb_xcc_id(); b.st = st;
    if (threadIdx.x == 0) (void)xb_add(&bar[XB_XCNT(b.x)], 1u);
    return b;
}
__device__ __forceinline__ void xcd_barrier_complete(unsigned* bar, unsigned x, unsigned& nloc, unsigned& nx) {
    const unsigned G = gridDim.x * gridDim.y * gridDim.z;
    unsigned sum, cnt, mine, sp = 0u;
    for (;;) {
        sum = 0u; cnt = 0u; mine = 0u;
#pragma unroll
        for (unsigned j = 0; j < 16; ++j) { const unsigned c = xb_ld(&bar[XB_XCNT(j)]); sum += c; cnt += (c > 0u) ? 1u : 0u; mine = (j == x) ? c : mine; }
        if (sum == G) break;
        __builtin_amdgcn_s_sleep(1);
        if ((++sp & 255u) == 0u) { if (xb_ld(&bar[XB_TMO])) break; if (sp > XB_SPIN_CAP) { atomicAdd(&bar[XB_TMO], 1u); break; } }
    }
    nloc = mine > 0u ? mine : 1u; nx = cnt > 0u ? cnt : 1u;
}

__device__ __forceinline__ void xcd_barrier(const XcdBarrier& b) {
    asm volatile("s_waitcnt vmcnt(0)" ::: "memory");
    __syncthreads();
    if (threadIdx.x == 0) {
        unsigned* bar = b.bar;
        __builtin_amdgcn_s_waitcnt(0);
        unsigned nloc = b.st[0], nx = b.st[1];
        if (nloc == 0u) { xcd_barrier_complete(bar, b.x, nloc, nx); b.st[0] = nloc; b.st[1] = nx; }
        const unsigned old = xb_add(&bar[XB_XSUB(b.x)], 1u);
        const unsigned gen = old / nloc;
        if (old + 1u == (gen + 1u) * nloc) {
            __builtin_amdgcn_fence(__ATOMIC_RELEASE, "agent");
            asm volatile("s_waitcnt vmcnt(0)" ::: "memory");
            const unsigned og = xb_add(&bar[XB_TOP], 1u);
            const unsigned tg = og / nx;
            if (og + 1u == (tg + 1u) * nx) xb_add(&bar[XB_TOPGEN], 1u);
            else XB_SPIN(xb_ld(&bar[XB_TOPGEN]) == tg, bar);
            __builtin_amdgcn_fence(__ATOMIC_ACQUIRE, "agent");
            xb_add(&bar[XB_XGEN(b.x)], 1u);
            asm volatile("s_waitcnt vmcnt(0)" ::: "memory");
        } else {
            XB_SPIN(xb_ld(&bar[XB_XGEN(b.x)]) == gen, bar);
            __builtin_amdgcn_fence(__ATOMIC_ACQUIRE, "agent");
            asm volatile("s_waitcnt vmcnt(0)" ::: "memory");
        }
    }
    __syncthreads();
}

__device__ __forceinline__ int opaque_tid() { int t = threadIdx.x; asm volatile("" : "+v"(t)); return t; }
#define GRID_SYNC() do { XcdBarrier xb_; xb_.bar = (unsigned*)(ARGS().ws + WS_BAR); xb_.x = xb_xcc_id(); xb_.st = (volatile LAS unsigned*)(ldsl + MISC_OFF) + 8; xcd_barrier(xb_); } while (0)
__device__ __forceinline__ int opaque_s(int v) { asm volatile("" : "+s"(v)); return v; }
typedef const __attribute__((address_space(4))) Args* KArgsPtr;
__device__ __forceinline__ KArgsPtr opaque_kargs() { KArgsPtr p = (KArgsPtr)__builtin_amdgcn_kernarg_segment_ptr(); asm volatile("" : "+s"(p)); return p; }
#define ARGS() (*opaque_kargs())
#define WSPTR() ({ unsigned char* w_ = ARGS().ws; asm volatile("" : "+s"(w_)); w_; })
__global__ void __launch_bounds__(NWAVES * 64, 2) mega_fwd(Args args_) {
    extern __shared__ __attribute__((aligned(16))) unsigned char lds[];
    cg::grid_group grid = cg::this_grid();
    LAS unsigned char* ldsl = (LAS unsigned char*)lds;
    if (threadIdx.x == 0) { volatile LAS unsigned* mq0_ = (volatile LAS unsigned*)(ldsl + MISC_OFF); mq0_[8] = 0u; mq0_[9] = 0u; }
    __syncthreads();
    (void)xcd_barrier_post((unsigned*)(ARGS().ws + WS_BAR), (volatile LAS unsigned*)(ldsl + MISC_OFF) + 8);
    grid.sync();
    const int G0 = gridDim.x, bx0 = blockIdx.x;
#define G opaque_s(G0)
#define bx opaque_s(bx0)

    {
        unsigned char* ws = WSPTR();
        const int tid = opaque_tid(), lane = tid & 63, wave = __builtin_amdgcn_readfirstlane(tid >> 6);
        const int gw = bx * NWAVES + wave, NGW = G * NWAVES;
        unsigned* ctl = (unsigned*)(ws + WS_CTL); float* ssq = (float*)(ws + WS_SSQ);
        float* cosT = (float*)(ws + WS_COS); float* sinT = (float*)(ws + WS_SIN);
        bf16* XB = (bf16*)(ws + WS_XB);
        if (bx == 0) for (int i = tid; i < 4096; i += NWAVES * 64) ctl[i] = 0u;
        for (int i = bx * (NWAVES * 64) + tid; i < M * 32; i += G * NWAVES * 64) {
            const int pos = i >> 5, fi = i & 31;
            const float invf = exp2f(-(float)fi * (13.287712379549449f / 32.0f));
            const float ang = (float)pos * invf;
            const double rev = (double)ang * 0.15915494309189535; const double fr_ = rev - rint(rev);
            const float f = (float)fr_;
            cosT[i] = __builtin_amdgcn_cosf(f); sinT[i] = __builtin_amdgcn_sinf(f);
        }
        for (int m = gw; m < M; m += NGW) {
            const f32x4* xr = (const f32x4*)(ARGS().in[0] + (size_t)m * 1024) + lane;
            unsigned long long* o8 = (unsigned long long*)(XB + (size_t)m * 1024) + lane; float s = 0.f;
            f32x4 v[4];
#pragma unroll
            for (int j = 0; j < 4; ++j) v[j] = xr[64 * j];
#pragma unroll
            for (int j = 0; j < 4; ++j) { s += (v[j].x * v[j].x + v[j].y * v[j].y) + (v[j].z * v[j].z + v[j].w * v[j].w);
                o8[64 * j] = (unsigned long long)pk2(v[j].x, v[j].y) | ((unsigned long long)pk2(v[j].z, v[j].w) << 32); }
            s = wave_sum(s); if (lane < 4) ssq[(size_t)m * 4 + lane] = lane == 0 ? s : 0.f;
        }
        conv_layer(ARGS(), 0, ws, (LAS float*)(ldsl + wave * 16384), gw, NGW, lane, 0, 3);
    }
    GRID_SYNC();

#pragma nounroll
    for (int step = 0; step < 6; ++step) {
        if (step % 3 != 1) {
            { unsigned char* ws = WSPTR(); const int kind = step % 3;
              pg8::Gemm g{(const bf16*)(ws + WS_XB), (const bf16*)(ws + WS_W + (kind == 0 ? W_GU1 : W_GU2)), M, 5632, 1024, 1024}; pg8::StaticOrder S; S.init(M, 5632, G, bx);
              pg8::EpiFFNUp E{(bf16*)(ws + WS_R1), (const float*)(ws + WS_SSQ) + (size_t)step * M * 4};
              pg8::gemm_phase<pg8::EpiFFNUp, pg8::StaticOrder, true, true>(ldsl, g, S, E); }
            {
                const int Gv = G, c = bx; const int rounds = (1408 + Gv - 1) / Gv, first_short = 1408 - (rounds - 1) * Gv;
                const bool all = first_short >= Gv;
                if (all || c >= first_short) {
                    unsigned char* ws = WSPTR(); const int tid = opaque_tid(), lane = tid & 63, wave = __builtin_amdgcn_readfirstlane(tid >> 6);
                    const int idx = all ? c : c - first_short, cnt = all ? Gv : Gv - first_short;
                    conv_layer(ARGS(), step == 0 ? 0 : 1, ws, (LAS float*)(ldsl + wave * 16384), idx * NWAVES + wave, cnt * NWAVES, lane, step == 0 ? 3 : (step == 2 ? 0 : (step == 3 ? 12 : 11)), step == 0 ? 12 : (step == 2 ? 11 : (step == 3 ? 14 : 12)));
                } }
            GRID_SYNC();
            { unsigned char* ws = WSPTR(); const int kind = step % 3;
              pg8::Gemm g{(const bf16*)(ws + WS_R1), (const bf16*)(ws + WS_W + (kind == 0 ? W_D1 : W_D2)), M, 1024, 2816, 2816}; pg8::StaticOrder S; S.init(M, 1024, G, bx);
              pg8::EpiResid E{step == 0 ? ARGS().in[0] : (const float*)ARGS().out, ARGS().out, (bf16*)(ws + WS_XB), (float*)(ws + WS_SSQ) + (size_t)(step + 1) * M * 4, 0.5f};
              pg8::gemm_phase<pg8::EpiResid, pg8::StaticOrder, false, true>(ldsl, g, S, E); }
            if (step != 5) GRID_SYNC();
        } else {
            { unsigned char* ws = WSPTR(); const int l = step / 3;
              pg8::Gemm g{(const bf16*)(ws + WS_XB), (const bf16*)(ws + WS_W + W_QKV), M, 2816, 1024, 1024}; pg8::StaticOrder S; S.init(M, 2816, G, bx);
              pg8::EpiQKV E{(bf16*)(ws + WS_R1), (const float*)(ws + WS_SSQ) + (size_t)step * M * 4, (const float*)(ws + WS_COS), (const float*)(ws + WS_SIN),
                            ARGS().in[7] + l * 64, ARGS().in[8] + l * 64, ARGS().in[9] + l * 64, ARGS().in[10] + l * 64, ARGS().in[12] + l * 64, ARGS().in[13] + l * 64, (float*)(ws + WS_KSUM), attn_body::C2};
              pg8::gemm_phase<pg8::EpiQKV, pg8::StaticOrder, true, true>(ldsl, g, S, E); }
            if (step == 1) {
                const int Gv = G, c = bx; const int rounds = (704 + Gv - 1) / Gv, first_short = 704 - (rounds - 1) * Gv; const bool all = first_short >= Gv;
                if (all || c >= first_short) {
                    unsigned char* ws = WSPTR(); const int tid = opaque_tid(), lane = tid & 63, wave = __builtin_amdgcn_readfirstlane(tid >> 6);
                    const int idx = all ? c : c - first_short, cnt = all ? Gv : Gv - first_short;
                    conv_layer(ARGS(), 0, ws, (LAS float*)(ldsl + wave * 16384), idx * NWAVES + wave, cnt * NWAVES, lane, 12, 14);
                } }
            GRID_SYNC();
            { unsigned char* ws = WSPTR(); const int l = step / 3;
              const attn_body::bf16* QKV = (const attn_body::bf16*)(ws + WS_R1);
              for (int u = bx; u < 256; u += G) { const int h = u >> 6, qb = u & 63;
                  attn_body::moba_gate(qb, QKV + 64 * h, (char*)lds, (const float*)(ws + WS_KSUM) + (size_t)h * 64 * 64, (unsigned*)(ws + WS_CTL) + 3072 + 256 * l + 64 * h, (int*)(ws + WS_MSEL) + (size_t)h * 16384 * 4); } }
            GRID_SYNC();
            { unsigned char* ws = WSPTR(); const int l = step / 3; const int tid = opaque_tid();
              volatile LAS int* T = (volatile LAS int*)(ldsl + MISC_OFF + 1024);
              const unsigned* cnt = (const unsigned*)(ws + WS_CTL) + 3072 + 256 * l;
              if (tid < 256) T[512 + tid] = 256 + (int)__hip_atomic_load(cnt + tid, __ATOMIC_RELAXED, __HIP_MEMORY_SCOPE_AGENT);
              __syncthreads();
              if (tid < 4) { int o = 0, c = 0; for (int b = 0; b < 64; ++b) { const int len = T[512 + tid * 64 + b]; T[tid * 64 + b] = o; T[256 + tid * 64 + b] = c; o += len; c += (len + 255) >> 8; } T[768 + tid] = c; }
              __syncthreads();
              if (tid < 256) { const int h = tid >> 6; const int add = (h > 0 ? T[768] : 0) + (h > 1 ? T[769] : 0) + (h > 2 ? T[770] : 0); T[256 + tid] += add; }
              if (tid == 0) T[772] = T[768] + T[769] + T[770] + T[771];
              __syncthreads();
              int* SEL = (int*)(ws + WS_MSEL); unsigned short* LIST = (unsigned short*)(ws + WS_MLIST);
              for (int e = bx * (NWAVES * 64) + tid; e < 4 * 16384; e += G * NWAVES * 64) { const int h = e >> 14, t = e & 16383;
                  int v0 = SEL[(size_t)e * 4 + 0], v1 = SEL[(size_t)e * 4 + 1], v2 = SEL[(size_t)e * 4 + 2];
                  if (v0 >= 0) { const int r = T[h * 64 + (v0 >> 16)] + 256 + (v0 & 0xffff); LIST[(size_t)h * 65536 + r] = (unsigned short)t; v0 = r; }
                  if (v1 >= 0) { const int r = T[h * 64 + (v1 >> 16)] + 256 + (v1 & 0xffff); LIST[(size_t)h * 65536 + r] = (unsigned short)t; v1 = r; }
                  if (v2 >= 0) { const int r = T[h * 64 + (v2 >> 16)] + 256 + (v2 & 0xffff); LIST[(size_t)h * 65536 + r] = (unsigned short)t; v2 = r; }
                  SEL[(size_t)e * 4 + 0] = v0; SEL[(size_t)e * 4 + 1] = v1; SEL[(size_t)e * 4 + 2] = v2; SEL[(size_t)e * 4 + 3] = T[h * 64 + (t >> 8)] + (t & 255); } }
            GRID_SYNC();
            { unsigned char* ws = WSPTR(); const int l = step / 3; const int tid = opaque_tid();
              volatile LAS unsigned* MISC = (volatile LAS unsigned*)(ldsl + MISC_OFF);
              volatile LAS int* T = (volatile LAS int*)(ldsl + MISC_OFF + 1024);
              unsigned* qctr = (unsigned*)(ws + WS_CTL) + 64 * (1 + l);
              const attn_body::bf16* QKV = (const attn_body::bf16*)(ws + WS_R1); attn_body::bf16* OBa = (attn_body::bf16*)(ws + WS_OB);
              const int TC = T[772];
              for (;;) {
                  if (tid == 0) MISC[0] = atomicAdd(qctr, 1u);
                  __syncthreads(); const int u = __builtin_amdgcn_readfirstlane((int)MISC[0]); __syncthreads();
                  if (u >= 1024 + TC + 256) break;
                  if (u < 1024) { const int qb = 63 - u / 16, hv = u % 16; const int h = hv >> 2, sub = hv & 3;
                      attn_body::attn_unit<0, 8>(qb, 0, QKV + 1280 + 128 * h + 64 * (sub >> 1), QKV + 1792 + 128 * h + 64 * (sub >> 1), QKV + 2304 + 128 * h + 64 * (sub & 1),
                                                 OBa + 512 + 256 * h + 128 * (sub >> 1) + 64 * (sub & 1), (char*)lds, nullptr, 0.f);
                  } else if (u < 1024 + TC) { const int j = u - 1024; int lo = 0, hi = 255;
                      while (lo < hi) { const int mid = (lo + hi + 1) >> 1; if (T[256 + mid] <= j) lo = mid; else hi = mid - 1; }
                      const int i = __builtin_amdgcn_readfirstlane(lo), h = i >> 6, b = i & 63, c = j - T[256 + i], rb = T[i] + 256 * c; const int n = T[512 + i] - 256 * c;
                      attn_body::bf16* PART = (h < 2 ? (attn_body::bf16*)(ws + WS_W + W_GU1) + (size_t)h * 65536 * 64 : (attn_body::bf16*)(ws + WS_OC) + (size_t)(h - 2) * 65536 * 64) + (size_t)rb * 64;
                      attn_body::attn_unit<3, 0>(b, 4 * b, QKV + 64 * h, QKV + 256 + 64 * h, QKV + 512 + 64 * h, PART, (char*)lds, nullptr, 0.f,
                                                 c == 0 ? nullptr : (const unsigned short*)(ws + WS_MLIST) + (size_t)h * 65536 + rb, n < 256 ? n : 256, (float*)(ws + WS_MSTAT) + (size_t)h * 65536 + rb);
                  } else { const int s = u - 1024 - TC, hq = s & 3, qb = s >> 2; const int t0 = qb == 0 ? 0 : 4 * qb - 2;
                      attn_body::attn_unit<2, 8>(qb, t0, QKV + 768 + 64 * hq, QKV + 1024 + 64 * (hq >> 1), QKV + 1152 + 64 * (hq >> 1), OBa + 256 + 64 * hq, (char*)lds, nullptr, ARGS().in[11][l * 4 + hq] * LOG2E); }
              } }
            GRID_SYNC();
            { unsigned char* ws = WSPTR(); const int tid = opaque_tid(), lane = tid & 63, wave = __builtin_amdgcn_readfirstlane(tid >> 6);
              const int gw = bx * NWAVES + wave, NGW = G * NWAVES; const int h = lane >> 4, j4 = (lane & 15) * 4;
              const bf16* PART = h < 2 ? (const bf16*)(ws + WS_W + W_GU1) + (size_t)h * 65536 * 64 : (const bf16*)(ws + WS_OC) + (size_t)(h - 2) * 65536 * 64;
              const float* ST = (const float*)(ws + WS_MSTAT) + (size_t)h * 65536; const int* SEL = (const int*)(ws + WS_MSEL) + (size_t)h * 16384 * 4; bf16* OB = (bf16*)(ws + WS_OB);
              for (int t0 = gw; t0 < 16384; t0 += 4 * NGW) {
                  typedef int i32x4 __attribute__((ext_vector_type(4)));
                  i32x4 rr[4]; float wl[4][4]; unsigned long long qv[4][4];
#pragma unroll
                  for (int k = 0; k < 4; ++k) rr[k] = *(const i32x4*)(SEL + (size_t)(t0 + k * NGW) * 4);
#pragma unroll
                  for (int k = 0; k < 4; ++k)
#pragma unroll
                      for (int q = 0; q < 4; ++q) { const int r = rr[k][q]; const int rc = r >= 0 ? r : 0; const float w = ST[rc]; wl[k][q] = r >= 0 ? w : -INFINITY; qv[k][q] = *(const unsigned long long*)(PART + (size_t)rc * 64 + j4); }
#pragma unroll
                  for (int k = 0; k < 4; ++k) { const int t = t0 + k * NGW;
                      const float mx = fmaxf(fmaxf(wl[k][0], wl[k][1]), fmaxf(wl[k][2], wl[k][3]));
                      float a0 = 0.f, a1 = 0.f, a2 = 0.f, a3 = 0.f, ws_ = 0.f;
#pragma unroll
                      for (int q = 0; q < 4; ++q) { const float w = __builtin_amdgcn_exp2f(wl[k][q] - mx); ws_ += w; const unsigned lo_ = (unsigned)qv[k][q], hi_ = (unsigned)(qv[k][q] >> 32);
                          a0 += w * __uint_as_float(lo_ << 16); a1 += w * __uint_as_float(lo_ & 0xffff0000u); a2 += w * __uint_as_float(hi_ << 16); a3 += w * __uint_as_float(hi_ & 0xffff0000u); }
                      const float inv = 1.0f / ws_;
                      *(unsigned long long*)(OB + (size_t)t * OPW + 64 * h + j4) = (unsigned long long)pk2(a0 * inv, a1 * inv) | ((unsigned long long)pk2(a2 * inv, a3 * inv) << 32); }
              } }
            { unsigned char* ws = WSPTR(); const int l = step / 3;
              const int tid = opaque_tid(), lane = tid & 63, wave = __builtin_amdgcn_readfirstlane(tid >> 6);
              const int gw = bx * NWAVES + wave, NGW = G * NWAVES;
              const bf16* OB = (const bf16*)(ws + WS_OB); bf16* OC = (bf16*)(ws + WS_OCN);
              const float lam_init = l == 0 ? 0.2f : 0.35550907f;
              const float s1 = wave_sum(ARGS().in[14][l * 64 + lane] * ARGS().in[15][l * 64 + lane]), s2 = wave_sum(ARGS().in[16][l * 64 + lane] * ARGS().in[17][l * 64 + lane]);
              const float lam = expf(s1) - expf(s2) + lam_init;
              const int h = lane >> 4, c0 = (lane & 15) * 8;
              f32x4 sg0 = *(const f32x4*)(ARGS().in[18] + l * 128 + c0), sg1 = *(const f32x4*)(ARGS().in[18] + l * 128 + c0 + 4);
              sg0 = sg0 * (1.0f - lam_init); sg1 = sg1 * (1.0f - lam_init);
              for (int m = gw; m < M; m += NGW) {
                  const bf16* op = OB + (size_t)m * OPW + 512 + 256 * h + c0;
                  f32x4 a0, a1, b0, b1; pg8::unpack8(*(const v4u*)op, a0, a1); pg8::unpack8(*(const v4u*)(op + 128), b0, b1);
                  a0 = a0 - b0 * lam; a1 = a1 - b1 * lam;
                  float ss = (a0[0] * a0[0] + a0[1] * a0[1]) + (a0[2] * a0[2] + a0[3] * a0[3]) + (a1[0] * a1[0] + a1[1] * a1[1]) + (a1[2] * a1[2] + a1[3] * a1[3]);
                  ss += __shfl_xor(ss, 1); ss += __shfl_xor(ss, 2); ss += __shfl_xor(ss, 4); ss += __shfl_xor(ss, 8);
                  const float rn = __builtin_amdgcn_rsqf(ss * (1.0f / 128.0f) + 1e-6f);
                  *(v4u*)(OC + (size_t)m * 512 + 128 * h + c0) = pg8::pack8(a0 * rn * sg0, a1 * rn * sg1);
              } }
            GRID_SYNC();
#define BRANCH_PAIR(WG_OFF, A_EXPR, KB, LDA, WB_OFF, FIRST) \
            { unsigned char* ws = WSPTR(); \
              pg8::Gemm g{(const bf16*)(ws + WS_XB), (const bf16*)(ws + WS_W + W_G + (WG_OFF)), M, 1024, 1024, 1024}; pg8::StaticOrder S; S.init(M, 1024, G, bx); \
              pg8::EpiGate E{(bf16*)(ws + WS_R1), (const float*)(ws + WS_SSQ) + (size_t)step * M * 4}; \
              pg8::gemm_phase<pg8::EpiGate, pg8::StaticOrder, true, true>(ldsl, g, S, E); } \
            { unsigned char* ws = WSPTR(); \
              pg8::Gemm g{(const bf16*)(A_EXPR), (const bf16*)(ws + WS_W + (WB_OFF)), M, 1024, (KB), (LDA)}; pg8::StaticOrder S; S.init(M, 1024, G, bx); \
              pg8::EpiBranch E{(const bf16*)(ws + WS_R1), (bf16*)(ws + WS_R1 + 32 * MiB), (FIRST)}; \
              pg8::gemm_phase<pg8::EpiBranch, pg8::StaticOrder, true, true>(ldsl, g, S, E); }
            BRANCH_PAIR((size_t)0, ws + WS_OB, 256, OPW, W_BA, 1)
            BRANCH_PAIR((size_t)1024 * 1024 * 2, ws + WS_OB + 512, 256, OPW, W_BB, 0)
            BRANCH_PAIR((size_t)2 * 1024 * 1024 * 2, ws + WS_OCN, 512, 512, W_BC, 0)
#undef BRANCH_PAIR
            GRID_SYNC();
            { unsigned char* ws = WSPTR();
              pg8::Gemm g{(const bf16*)(ws + WS_R1 + 32 * MiB), (const bf16*)(ws + WS_W + W_O), M, 1024, 1024, 1024}; pg8::StaticOrder S; S.init(M, 1024, G, bx);
              pg8::EpiResid E{(const float*)ARGS().out, ARGS().out, (bf16*)(ws + WS_XB), (float*)(ws + WS_SSQ) + (size_t)(step + 1) * M * 4, 1.0f};
              pg8::gemm_phase<pg8::EpiResid, pg8::StaticOrder, false, true>(ldsl, g, S, E); }
            GRID_SYNC();
        }
    }
}

#undef G
#undef bx
extern "C" void kernel_launch(void* const* d_in, const int* in_sizes, int n_in, void* d_out, int out_size, void* d_ws, size_t ws_size, hipStream_t stream) {
    static int grid = 0;
    if (grid == 0) {
        if (n_in != 27 || out_size != M * DMODEL || ws_size < WS_END) { fprintf(stderr, "kernel_launch: unexpected shapes (n_in %d out %d ws %zu)\n", n_in, out_size, ws_size); grid = -1; return; }
        int dev = 0, cus = 0, per_cu = 0;
        hipGetDevice(&dev); hipDeviceGetAttribute(&cus, hipDeviceAttributeMultiprocessorCount, dev);
        hipFuncSetAttribute((const void*)mega_fwd, hipFuncAttributeMaxDynamicSharedMemorySize, LDS_BYTES);
        hipOccupancyMaxActiveBlocksPerMultiprocessor(&per_cu, (const void*)mega_fwd, NWAVES * 64, LDS_BYTES);
        if (per_cu < 1) { fprintf(stderr, "kernel_launch: occupancy query says %d blocks per CU\n", per_cu); per_cu = 1; }
        (void)hipGetLastError();
        grid = cus;
    }
    if (grid < 0) return;
    (void)hipMemsetAsync((char*)d_ws + WS_BAR, 0, 16384, stream);
    Args a{};
    for (int i = 0; i < 27; ++i) a.in[i] = (const float*)d_in[i];
    a.out = (float*)d_out; a.ws = (unsigned char*)d_ws;
    void* kargs[] = {&a};
    hipError_t e = hipLaunchCooperativeKernel((const void*)mega_fwd, dim3(grid), dim3(NWAVES * 64), kargs, LDS_BYTES, stream);
    if (e != hipSuccess) fprintf(stderr, "cooperative launch failed: %s (grid %d)\n", hipGetErrorString(e), grid);
}
```

```cpp
#include <hip/hip_runtime.h>
#include <cstdio>
#include <cstdint>
#include <hip/hip_cooperative_groups.h>
namespace pg8 {
#define PG8_LAS __attribute__((address_space(3)))
typedef unsigned short bf16_t;
typedef short bf16x8 __attribute__((ext_vector_type(8)));
typedef float f32x4 __attribute__((ext_vector_type(4)));
typedef unsigned u32x4 __attribute__((ext_vector_type(4)));
constexpr int BM = 256, BK = 64, HALF = 128, HTB = HALF * BK * 2  , STAGE_BYTES = 8 * HTB, NXCD = 8, WGM = 8;

__host__ __device__ __forceinline__ int lds_byte(int r, int c) { const int st = (r >> 4) * 2 + (c >> 5), rr = r & 15, cc = c & 31, ob = rr * 64 + cc * 2; return st * 1024 + (ob ^ (((ob >> 9) & 1) << 5)); }
__host__ __device__ __forceinline__ void stage_rc(int b, int& R, int& C) { const int st = b / 1024, sb = b % 1024, swz = sb ^ (((sb >> 9) & 1) << 5); R = (st >> 1) * 16 + swz / 64; C = (st & 1) * 32 + (swz % 64) / 2; }
__host__ __device__ __forceinline__ int perm32(int rho) { const int n = rho >> 4, i = rho & 15; return 8 * (i >> 2) + 4 * n + (i & 3); }

struct Unit { int pm, pn; };
struct Gemm { const bf16_t* A; const bf16_t* Bt; int M, N, K, lda; };

struct StaticOrder {
    int nM, nN, nwg, G, c;
    __host__ __device__ void init(int M, int N, int G_, int c_) { nM = M / BM; nN = N / BM; nwg = nM * nN; G = G_; c = c_; }
    __host__ __device__ bool next(int i, Unit& u) const {
        const long L = (long)i * G + c; if (L >= nwg) return false;
        int wgid = (int)L; { const int q = nwg / NXCD, r = nwg % NXCD, xcd = wgid % NXCD, off = wgid / NXCD; wgid = (xcd < r ? xcd * (q + 1) : r * (q + 1) + (xcd - r) * q) + off; }
        const int nig = WGM * nN, gid = wgid / nig, fm = gid * WGM, gsz = (nM - fm) < WGM ? (nM - fm) : WGM;
        u.pm = fm + ((wgid % nig) % gsz); u.pn = (wgid % nig) / gsz; return true;
    }
    __device__ __forceinline__ void a_ready(const Unit&) const {}
    __device__ __forceinline__ void done(const Unit&) const {}
};

typedef float f32x2_t __attribute__((ext_vector_type(2))); typedef __bf16 bf16x2_t __attribute__((ext_vector_type(2)));
__device__ __forceinline__ unsigned cvt_pk_bf16(float lo, float hi) { f32x2_t v = {lo, hi}; bf16x2_t b = __builtin_convertvector(v, bf16x2_t); return __builtin_bit_cast(unsigned, b); }
__device__ __forceinline__ u32x4 pack8(const f32x4 a, const f32x4 b) { u32x4 w; w.x = cvt_pk_bf16(a[0], a[1]); w.y = cvt_pk_bf16(a[2], a[3]); w.z = cvt_pk_bf16(b[0], b[1]); w.w = cvt_pk_bf16(b[2], b[3]); return w; }
__device__ __forceinline__ void unpack8(const u32x4 w, f32x4& a, f32x4& b) {
    a[0] = __uint_as_float(w.x << 16); a[1] = __uint_as_float(w.x & 0xffff0000u); a[2] = __uint_as_float(w.y << 16); a[3] = __uint_as_float(w.y & 0xffff0000u);
    b[0] = __uint_as_float(w.z << 16); b[1] = __uint_as_float(w.z & 0xffff0000u); b[2] = __uint_as_float(w.w << 16); b[3] = __uint_as_float(w.w & 0xffff0000u); }
__device__ __forceinline__ float rstd_of(const float* ssq, int row) { const f32x4 a = *(const f32x4*)(ssq + (size_t)row * 4);
    return __builtin_amdgcn_rsqf(((a[0] + a[1]) + (a[2] + a[3])) * (1.0f / 1024.0f) + 1e-6f); }
__device__ __forceinline__ float sigm(float g) { return __builtin_amdgcn_rcpf(1.0f + __builtin_amdgcn_exp2f(-1.4426950408889634f * g)); }

struct EpiFFNUp {
    static constexpr bool PERM = false, AFTER_DRAIN = false;
    bf16_t* O; const float* ssq;
    __device__ __forceinline__ void operator()(const f32x4 (&acc)[2][2][4][2], const Unit& u, int wr, int wc, int fr, int fq) const {
        const int row0 = u.pm * BM + wr * 64 + fr, col0 = u.pn * 128 + wc * 32 + 8 * fq;
#pragma unroll
        for (int ai = 0; ai < 2; ++ai)
#pragma unroll
            for (int m = 0; m < 4; ++m) { if (m == 0) asm volatile("" ::: "memory"); const int row = row0 + ai * HALF + m * 16; const float rs = rstd_of(ssq, row);
                f32x4 o[2];
#pragma unroll
                for (int n = 0; n < 2; ++n) { const f32x4 g = acc[ai][0][m][n] * rs, up = acc[ai][1][m][n] * rs;
#pragma unroll
                    for (int e = 0; e < 4; ++e) o[n][e] = g[e] * sigm(g[e]) * up[e]; }
                *(u32x4*)(O + (size_t)row * 2816 + col0) = pack8(o[0], o[1]); }
    }
};
struct EpiResid {
    static constexpr bool PERM = false, AFTER_DRAIN = true;
    const float* Xin; float* X; bf16_t* XB; float* ssq_out; float scale;
    __device__ __forceinline__ void fused(const f32x4 (&acc)[2][2][4][2], const Unit& u, int wr, int wc, int fr, int fq, PG8_LAS unsigned char* lds, int wid, int lane) const {
        PG8_LAS float* P = (PG8_LAS float*)lds;
        const int row0 = u.pm * BM + wr * 64 + fr, col0 = u.pn * BM + wc * 32 + 8 * fq;
#pragma unroll
        for (int ai = 0; ai < 2; ++ai)
#pragma unroll
            for (int m = 0; m < 4; ++m) { if ((m & 1) == 0) asm volatile("" ::: "memory"); const int row = row0 + ai * HALF + m * 16; float ss = 0.f;
#pragma unroll
                for (int bj = 0; bj < 2; ++bj) { float* p = X + (size_t)row * 1024 + col0 + bj * HALF; const float* pi = Xin + (size_t)row * 1024 + col0 + bj * HALF;
                    f32x4 x0 = *(const f32x4*)pi, x1 = *(const f32x4*)(pi + 4);
                    x0 = x0 + acc[ai][bj][m][0] * scale; x1 = x1 + acc[ai][bj][m][1] * scale;
                    *(f32x4*)p = x0; *(f32x4*)(p + 4) = x1;
                    ss += (x0[0] * x0[0] + x0[1] * x0[1]) + (x0[2] * x0[2] + x0[3] * x0[3]) + (x1[0] * x1[0] + x1[1] * x1[1]) + (x1[2] * x1[2] + x1[3] * x1[3]);
                    *(u32x4*)(XB + (size_t)row * 1024 + col0 + bj * HALF) = pack8(x0, x1); }
                ss += __shfl_xor(ss, 16); ss += __shfl_xor(ss, 32);
                if (fq == 0) P[(ai * HALF + wr * 64 + m * 16 + fr) * 4 + wc] = ss; }
        asm volatile("s_waitcnt lgkmcnt(0)" ::: "memory"); __builtin_amdgcn_s_barrier(); asm volatile("" ::: "memory");
        { const int r = wid * 32 + (lane & 31);
          if (lane < 32) { const f32x4 q = *(const PG8_LAS f32x4*)(P + r * 4); ssq_out[(size_t)(u.pm * BM + r) * 4 + u.pn] = (q[0] + q[1]) + (q[2] + q[3]); } }
        asm volatile("s_waitcnt lgkmcnt(0)" ::: "memory"); __builtin_amdgcn_s_barrier(); asm volatile("" ::: "memory");
    }
};
struct EpiGate {
    static constexpr bool PERM = false, AFTER_DRAIN = false;
    bf16_t* O; const float* ssq;
    __device__ __forceinline__ void operator()(const f32x4 (&acc)[2][2][4][2], const Unit& u, int wr, int wc, int fr, int fq) const {
        const int row0 = u.pm * BM + wr * 64 + fr, col0 = u.pn * BM + wc * 32 + 8 * fq;
#pragma unroll
        for (int ai = 0; ai < 2; ++ai)
#pragma unroll
            for (int m = 0; m < 4; ++m) { if (m == 0) asm volatile("" ::: "memory"); const int row = row0 + ai * HALF + m * 16; const float rs = rstd_of(ssq, row);
#pragma unroll
                for (int bj = 0; bj < 2; ++bj) { f32x4 o[2];
#pragma unroll
                    for (int n = 0; n < 2; ++n)
#pragma unroll
                        for (int e = 0; e < 4; ++e) o[n][e] = sigm(acc[ai][bj][m][n][e] * rs);
                    *(u32x4*)(O + (size_t)row * 1024 + col0 + bj * HALF) = pack8(o[0], o[1]); } }
    }
    __device__ __forceinline__ void fused(const f32x4 (&acc)[2][2][4][2], const Unit& u, int wr, int wc, int fr, int fq, PG8_LAS unsigned char*, int, int) const { (*this)(acc, u, wr, wc, fr, fq); }
};
struct EpiBranch {
    static constexpr bool PERM = false, AFTER_DRAIN = false;
    const bf16_t* G; bf16_t* Mg; int first;
    __device__ __forceinline__ void operator()(const f32x4 (&acc)[2][2][4][2], const Unit& u, int wr, int wc, int fr, int fq) const {
        const int row0 = u.pm * BM + wr * 64 + fr, col0 = u.pn * BM + wc * 32 + 8 * fq;
#pragma unroll
        for (int ai = 0; ai < 2; ++ai)
#pragma unroll
            for (int m = 0; m < 4; ++m) { if ((m & 1) == 0) asm volatile("" ::: "memory"); const int row = row0 + ai * HALF + m * 16;
#pragma unroll
                for (int bj = 0; bj < 2; ++bj) { const size_t off = (size_t)row * 1024 + col0 + bj * HALF;
                    f32x4 g0, g1; unpack8(*(const u32x4*)(G + off), g0, g1);
                    f32x4 o0 = acc[ai][bj][m][0] * g0, o1 = acc[ai][bj][m][1] * g1;
                    if (!first) { f32x4 p0, p1; unpack8(*(const u32x4*)(Mg + off), p0, p1); o0 = o0 + p0; o1 = o1 + p1; }
                    *(u32x4*)(Mg + off) = pack8(o0, o1); } }
    }
    __device__ __forceinline__ void fused(const f32x4 (&acc)[2][2][4][2], const Unit& u, int wr, int wc, int fr, int fq, PG8_LAS unsigned char*, int, int) const { (*this)(acc, u, wr, wc, fr, fq); }
};
struct EpiQKV {
    static constexpr bool PERM = false, AFTER_DRAIN = false;
    bf16_t* O; const float* ssq; const float* cosT; const float* sinT;
    const float *gqa, *gka, *gqb, *gkb, *gqc, *gkc; float* ksum; float c2;
    __device__ __forceinline__ void operator()(const f32x4 (&acc)[2][2][4][2], const Unit& u, int wr, int wc, int fr, int fq) const {
        const int g = 4 * u.pn + wc; const int row0 = u.pm * BM + wr * 64 + fr;
        int kind = 0; const float* gp = gqa; float osc = 1.f; bool dok = false;
        if (g < 4) { kind = 1; gp = gqa; osc = c2; } else if (g < 8) { kind = 1; gp = gka; dok = true; } else if (g < 12) { kind = 0; }
        else if (g < 16) { kind = 1; gp = gqb; osc = c2; } else if (g < 18) { kind = 1; gp = gkb; } else if (g < 20) { kind = 0; }
        else if (g < 28) { kind = 1; gp = gqc; osc = c2; } else if (g < 36) { kind = 1; gp = gkc; } else { kind = 0; }
        bf16_t* ob = O + 64 * g + 8 * fq;
        if (kind == 0) {
#pragma unroll
            for (int ai = 0; ai < 2; ++ai)
#pragma unroll
                for (int m = 0; m < 4; ++m) { if (m == 0) asm volatile("" ::: "memory"); const int row = row0 + ai * HALF + m * 16; const float rs = rstd_of(ssq, row);
#pragma unroll
                    for (int bj = 0; bj < 2; ++bj) *(u32x4*)(ob + (size_t)row * 2816 + 32 * bj) = pack8(acc[ai][bj][m][0] * rs, acc[ai][bj][m][1] * rs); }
        } else {
            f32x4 gv[2][2], cs[2][2];
#pragma unroll
            for (int bj = 0; bj < 2; ++bj)
#pragma unroll
                for (int n = 0; n < 2; ++n) { gv[bj][n] = *(const f32x4*)(gp + 32 * bj + 8 * fq + 4 * n); cs[bj][n] = (f32x4){0.f, 0.f, 0.f, 0.f}; }
#pragma unroll
            for (int ai = 0; ai < 2; ++ai)
#pragma unroll
                for (int m = 0; m < 4; ++m) { if (m == 0) asm volatile("" ::: "memory"); const int row = row0 + ai * HALF + m * 16; const float rs = rstd_of(ssq, row);
                    f32x4 v[2][2]; float ss = 0.f;
#pragma unroll
                    for (int bj = 0; bj < 2; ++bj)
#pragma unroll
                        for (int n = 0; n < 2; ++n) { v[bj][n] = acc[ai][bj][m][n] * rs; const f32x4 q = v[bj][n] * v[bj][n]; ss += (q[0] + q[1]) + (q[2] + q[3]); }
                    ss += __shfl_xor(ss, 16); ss += __shfl_xor(ss, 32);
                    const float rn = __builtin_amdgcn_rsqf(ss * (1.0f / 64.0f) + 1e-6f);
                    f32x4 o[2][2];
#pragma unroll
                    for (int n = 0; n < 2; ++n) { const f32x4 c = *(const f32x4*)(cosT + (size_t)row * 32 + 8 * fq + 4 * n), s = *(const f32x4*)(sinT + (size_t)row * 32 + 8 * fq + 4 * n);
                        const f32x4 y1 = v[0][n] * rn * gv[0][n], y2 = v[1][n] * rn * gv[1][n];
                        o[0][n] = y1 * c - y2 * s; o[1][n] = y2 * c + y1 * s; }
                    if (dok) {
#pragma unroll
                        for (int bj = 0; bj < 2; ++bj)
#pragma unroll
                            for (int n = 0; n < 2; ++n) cs[bj][n] = cs[bj][n] + o[bj][n]; }
#pragma unroll
                    for (int bj = 0; bj < 2; ++bj) *(u32x4*)(ob + (size_t)row * 2816 + 32 * bj) = pack8(o[bj][0] * osc, o[bj][1] * osc); }
            if (dok) {
#pragma unroll
                for (int bj = 0; bj < 2; ++bj)
#pragma unroll
                    for (int n = 0; n < 2; ++n)
#pragma unroll
                        for (int e = 0; e < 4; ++e) { float t = cs[bj][n][e]; t += __shfl_xor(t, 1); t += __shfl_xor(t, 2); t += __shfl_xor(t, 4); t += __shfl_xor(t, 8); cs[bj][n][e] = t; }
                if (fr == 0) { float* kp = ksum + ((size_t)((wr * 4 + (g - 4)) * 64 + u.pm)) * 64 + 8 * fq;
#pragma unroll
                    for (int bj = 0; bj < 2; ++bj)
#pragma unroll
                        for (int n = 0; n < 2; ++n) *(f32x4*)(kp + 32 * bj + 4 * n) = cs[bj][n]; }
            }
        }
    }
};

template <class Epi, class Sched, bool ALIGN_EPI = false, bool SP2 = false>
__device__ __forceinline__ void gemm_phase(PG8_LAS unsigned char* lds, const Gemm g, const Sched& S, const Epi& E) {
    int tid_ = threadIdx.x; asm volatile("" : "+v"(tid_)); const int tid = tid_, wid = __builtin_amdgcn_readfirstlane(tid >> 6), lane = tid & 63, wr = wid >> 2, wc = wid & 3, fr = lane & 15, fq = lane >> 4;
    const int K = g.K, nt = K / BK;
    unsigned voffA[2], voffB[2];
#pragma unroll
    for (int i = 0; i < 2; ++i) { int R, C; stage_rc(tid * 16 + i * 8192, R, C); const int Rb = Epi::PERM ? ((R & ~31) + perm32(R & 31)) : R;
        voffA[i] = (unsigned)(R * g.lda + C) * 2u; voffB[i] = (unsigned)(Rb * K + C) * 2u; }
    const size_t kstep = (size_t)(BK * 2);
    const size_t hstepB = (size_t)HALF * K * 2, hstepA = (size_t)HALF * g.lda * 2;
    const size_t tstepB = 2 * hstepB, tstepA = 2 * hstepA;
    const unsigned ldsw = (unsigned)wid * 1024u;
    const int aoff = lds_byte(wr * 64 + fr, fq * 8), boff = lds_byte(wc * 32 + fr, fq * 8);
#define PG8_SA(b, h) (((b) * 2 + (h)) * HTB)
#define PG8_SB(b, h) ((4 + (b) * 2 + (h)) * HTB)
#define PG8_STAGE(bufoff, gbase, voff) do { _Pragma("unroll") for (int _i = 0; _i < 2; ++_i) \
        __builtin_amdgcn_global_load_lds((const unsigned*)((const char*)(gbase) + (voff)[_i]), (PG8_LAS unsigned*)(lds + (bufoff) + ldsw + _i * 8192), 16, 0, 0); } while (0)
#define PG8_LDA(dst, b, h) do { _Pragma("unroll") for (int m = 0; m < 4; ++m) _Pragma("unroll") for (int k = 0; k < 2; ++k) dst[m][k] = *(const PG8_LAS bf16x8*)(lds + PG8_SA(b, h) + aoff + m * 2048 + k * 1024); } while (0)
#define PG8_LDB(dst, b, h) do { _Pragma("unroll") for (int n = 0; n < 2; ++n) _Pragma("unroll") for (int k = 0; k < 2; ++k) dst[n][k] = *(const PG8_LAS bf16x8*)(lds + PG8_SB(b, h) + boff + n * 2048 + k * 1024); } while (0)
#define PG8_MMA(ai, bj, At, Bt) do { __builtin_amdgcn_s_setprio(1); _Pragma("unroll") for (int m = 0; m < 4; ++m) _Pragma("unroll") for (int n = 0; n < 2; ++n) _Pragma("unroll") for (int k = 0; k < 2; ++k) \
        acc[ai][bj][m][n] = __builtin_amdgcn_mfma_f32_16x16x32_bf16(Bt[n][k], At[m][k], acc[ai][bj][m][n], 0, 0, 0); __builtin_amdgcn_s_setprio(0); } while (0)
#define PG8_WAIT_V(n) asm volatile("s_waitcnt vmcnt(" #n ")" ::: "memory")
#define PG8_WAIT_L(n) asm volatile("s_waitcnt lgkmcnt(" #n ")" ::: "memory")
#define PG8_BAR __builtin_amdgcn_s_barrier()
#define PG8_SCHED __builtin_amdgcn_sched_barrier(0)
    Unit cur, nxt; int ui = 0;
    if (!S.next(0, cur)) return;
    f32x4 acc[2][2][4][2];
#pragma unroll
    for (int a = 0; a < 2; ++a)
#pragma unroll
        for (int b = 0; b < 2; ++b)
#pragma unroll
            for (int m = 0; m < 4; ++m)
#pragma unroll
                for (int n = 0; n < 2; ++n) acc[a][b][m][n] = (f32x4){0.f, 0.f, 0.f, 0.f};
    bf16x8 At[4][2], B0[2][2], B1[2][2];
    const char* cA = (const char*)g.A + (size_t)cur.pm * tstepA; const char* cB = (const char*)g.Bt + (size_t)cur.pn * tstepB;
    S.a_ready(cur);
    if constexpr (SP2) {
        PG8_STAGE(PG8_SB(0, 0), cB, voffB); PG8_STAGE(PG8_SB(0, 1), cB + hstepB, voffB); PG8_STAGE(PG8_SA(0, 0), cA, voffA); PG8_STAGE(PG8_SA(0, 1), cA + hstepA, voffA);
        if (wr == 1) PG8_BAR;
        PG8_WAIT_V(2); PG8_BAR;
        PG8_STAGE(PG8_SB(1, 0), cB + kstep, voffB); PG8_STAGE(PG8_SA(1, 0), cA + kstep, voffA); PG8_STAGE(PG8_SB(1, 1), cB + hstepB + kstep, voffB);
        PG8_WAIT_V(6); PG8_BAR;
    } else {
        PG8_STAGE(PG8_SB(0, 0), cB, voffB); PG8_STAGE(PG8_SA(0, 0), cA, voffA); PG8_STAGE(PG8_SB(0, 1), cB + hstepB, voffB); PG8_STAGE(PG8_SA(0, 1), cA + hstepA, voffA);
        if (wr == 1) PG8_BAR;
        PG8_WAIT_V(4); PG8_BAR;
        PG8_STAGE(PG8_SB(1, 0), cB + kstep, voffB); PG8_STAGE(PG8_SA(1, 0), cA + kstep, voffA); PG8_STAGE(PG8_SB(1, 1), cB + hstepB + kstep, voffB);
        PG8_WAIT_V(6); PG8_BAR;
    }
    for (;;) {
        const bool has_next = S.next(ui + 1, nxt);
        const char* nA = has_next ? (const char*)g.A + (size_t)nxt.pm * tstepA : cA; const char* nB = has_next ? (const char*)g.Bt + (size_t)nxt.pn * tstepB : cB;
        for (int t = 0; t < nt; t += 2) {
            const bool last = (t == nt - 2);
            const char* a1 = cA + (size_t)(t + 1) * kstep;
            const char* a2 = last ? nA : cA + (size_t)(t + 2) * kstep; const char* b2 = last ? nB : cB + (size_t)(t + 2) * kstep;
            const char* a3 = a2 + kstep; const char* b3 = b2 + kstep;
            if (last && has_next) S.a_ready(nxt);
            if constexpr (SP2) {
            PG8_LDB(B0, 0, 0); PG8_LDB(B1, 0, 1); PG8_SCHED; PG8_LDA(At, 0, 0); PG8_STAGE(PG8_SA(1, 1), a1 + hstepA, voffA);
            PG8_WAIT_V(8); PG8_WAIT_L(0); PG8_BAR; PG8_MMA(0, 0, At, B0); PG8_MMA(0, 1, At, B1); PG8_BAR; PG8_SCHED;
            PG8_LDA(At, 0, 1); PG8_STAGE(PG8_SB(0, 0), b2, voffB); PG8_STAGE(PG8_SB(0, 1), b2 + hstepB, voffB); PG8_STAGE(PG8_SA(0, 0), a2, voffA);
            PG8_WAIT_V(8); PG8_WAIT_L(0); PG8_BAR; PG8_MMA(1, 0, At, B0); PG8_MMA(1, 1, At, B1); PG8_BAR; PG8_SCHED;
            PG8_LDB(B0, 1, 0); PG8_LDB(B1, 1, 1); PG8_SCHED; PG8_LDA(At, 1, 0); PG8_STAGE(PG8_SA(0, 1), a2 + hstepA, voffA);
            PG8_WAIT_V(8); PG8_WAIT_L(0); PG8_BAR; PG8_MMA(0, 0, At, B0); PG8_MMA(0, 1, At, B1); PG8_BAR; PG8_SCHED;
            PG8_LDA(At, 1, 1); PG8_STAGE(PG8_SB(1, 0), b3, voffB); PG8_STAGE(PG8_SB(1, 1), b3 + hstepB, voffB); PG8_STAGE(PG8_SA(1, 0), a3, voffA);
            PG8_WAIT_V(8); PG8_WAIT_L(0); PG8_BAR; PG8_MMA(1, 0, At, B0); PG8_MMA(1, 1, At, B1); PG8_BAR; PG8_SCHED;
            } else {
            PG8_LDB(B0, 0, 0); PG8_SCHED; PG8_LDA(At, 0, 0); PG8_STAGE(PG8_SA(1, 1), a1 + hstepA, voffA);
            PG8_WAIT_L(8); PG8_BAR; PG8_WAIT_L(0); PG8_MMA(0, 0, At, B0); PG8_BAR; PG8_SCHED;
            PG8_LDB(B1, 0, 1); PG8_STAGE(PG8_SB(0, 0), b2, voffB);
            PG8_BAR; PG8_WAIT_L(0); PG8_MMA(0, 1, At, B1); PG8_BAR;
            PG8_LDA(At, 0, 1); PG8_STAGE(PG8_SA(0, 0), a2, voffA);
            PG8_BAR; PG8_WAIT_L(0); PG8_MMA(1, 0, At, B0); PG8_BAR; PG8_SCHED;
            PG8_STAGE(PG8_SB(0, 1), b2 + hstepB, voffB);
            PG8_WAIT_V(6); PG8_BAR; PG8_MMA(1, 1, At, B1); PG8_BAR;
            PG8_LDB(B0, 1, 0); PG8_SCHED; PG8_LDA(At, 1, 0); PG8_STAGE(PG8_SA(0, 1), a2 + hstepA, voffA);
            PG8_WAIT_L(8); PG8_BAR; PG8_WAIT_L(0); PG8_MMA(0, 0, At, B0); PG8_BAR; PG8_SCHED;
            PG8_LDB(B1, 1, 1); PG8_STAGE(PG8_SB(1, 0), b3, voffB);
            PG8_BAR; PG8_WAIT_L(0); PG8_MMA(0, 1, At, B1); PG8_BAR;
            PG8_LDA(At, 1, 1); PG8_STAGE(PG8_SA(1, 0), a3, voffA);
            PG8_BAR; PG8_WAIT_L(0); PG8_MMA(1, 0, At, B0); PG8_BAR; PG8_SCHED;
            PG8_STAGE(PG8_SB(1, 1), b3 + hstepB, voffB);
            PG8_WAIT_V(6); PG8_BAR; PG8_MMA(1, 1, At, B1); PG8_BAR;
            }
        }
        if constexpr (ALIGN_EPI) { if (wr == 0) PG8_BAR; }
        if constexpr (!Epi::AFTER_DRAIN) { E(acc, cur, wr, wc, fr, fq); S.done(cur); }
        if (!has_next) break;
#pragma unroll
        for (int a = 0; a < 2; ++a)
#pragma unroll
            for (int b = 0; b < 2; ++b)
#pragma unroll
                for (int m = 0; m < 4; ++m)
#pragma unroll
                    for (int n = 0; n < 2; ++n) acc[a][b][m][n] = (f32x4){0.f, 0.f, 0.f, 0.f};
        cur = nxt; cA = nA; cB = nB; ++ui;
        if constexpr (ALIGN_EPI) { if (wr == 1) PG8_BAR; }
    }
    PG8_WAIT_V(0);
    if constexpr (!ALIGN_EPI) { if (wr == 0) PG8_BAR; }
    PG8_BAR;
    if constexpr (Epi::AFTER_DRAIN) { E.fused(acc, cur, wr, wc, fr, fq, lds, wid, lane); S.done(cur); }
#undef PG8_SA
#undef PG8_SB
#undef PG8_STAGE
#undef PG8_LDA
#undef PG8_LDB
#undef PG8_MMA
#undef PG8_WAIT_V
#undef PG8_WAIT_L
#undef PG8_BAR
#undef PG8_SCHED
}
}

#ifndef PG8_SP2
#define PG8_SP2 true
#endif
#ifndef PG8_ALIGN
#define PG8_ALIGN true
#endif

#include <hip/hip_bf16.h>
#include <cmath>
namespace attn_body {
using bf16=__hip_bfloat16;
using bf16x8=__attribute__((ext_vector_type(8)))short;
using s16x4=__attribute__((ext_vector_type(4)))short;
using f32x16=__attribute__((ext_vector_type(16)))float;
using u32x4=__attribute__((ext_vector_type(4)))unsigned;
constexpr int D=64,DM=2816,OPITCH=1536;
constexpr int NW=8,QBLK=32,QB=QBLK*NW,KVBLK=64;
constexpr int ATTN_PITCH=DM, ATTN_UNIT_ROWS=QB;
__device__ __forceinline__ int crow(int r,int hi){return (r&3)+8*(r>>2)+4*hi;}
#define SBAR() __builtin_amdgcn_sched_barrier(0)
constexpr float NEGV=-1000.0f;
__device__ __forceinline__ void cmask(f32x16&p0,f32x16&p1,int jb,int qrel,int hi){
  const float NEG=NEGV; int kb=64*jb+4*hi;
  #pragma unroll
  for(int r=0;r<16;++r){int kv=kb+(r&3)+8*(r>>2); if(kv>qrel)p0[r]=NEG; if(kv+32>qrel)p1[r]=NEG;}
}
__device__ __forceinline__ void swamask(f32x16&p0,f32x16&p1,int jb,int qrel,int hi){
  const float NEG=NEGV; int kb=64*jb+4*hi;
  #pragma unroll
  for(int r=0;r<16;++r){int kv=kb+(r&3)+8*(r>>2); if(kv>qrel||kv<qrel-127)p0[r]=NEG; if(kv+32>qrel||kv+32<qrel-127)p1[r]=NEG;}
}
__device__ __forceinline__ void mobamask(f32x16&p0,f32x16&p1,unsigned long long sel,int b){
  const float NEG=NEGV; const bool keep=((sel>>b)&1ull)!=0ull;
  #pragma unroll
  for(int r=0;r<16;++r){ p0[r]=keep?p0[r]:NEG; p1[r]=keep?p1[r]:NEG; }
}

constexpr int NSLOT=3, SLOTB=8192;
constexpr int LDS_K=0, LDS_V=NSLOT*SLOTB, LDS_WS=2*NSLOT*SLOTB, LDS_OST=LDS_WS+NW*64*4, LDS_BYTES=LDS_OST+NW*4096;
constexpr float C2=0.125f*1.4426950408889634f;
__device__ __forceinline__ void glds16(const void*gsrc,unsigned lds_dst){unsigned keep;
  asm volatile("s_mov_b32 %0, m0\n\ts_mov_b32 m0, %2\n\ts_nop 0\n\tglobal_load_lds_dwordx4 %1, off\n\ts_mov_b32 m0, %0":"=&s"(keep):"v"(gsrc),"s"(lds_dst):"memory");}
__device__ __forceinline__ float max3f(float a,float b,float c){float r;asm("v_max3_f32 %0, %1, %2, %3":"=v"(r):"v"(a),"v"(b),"v"(c));return r;}
__device__ __forceinline__ float max2f(float a,float b){float r;asm("v_max_f32_e32 %0, %1, %2":"=v"(r):"v"(a),"v"(b));return r;}
__device__ __forceinline__ float fadd_s(float a,float b){float r;asm("v_add_f32_e32 %0, %1, %2":"=v"(r):"v"(a),"v"(b));return r;}
__device__ __forceinline__ float fsub_s(float a,float b){float r;asm("v_sub_f32_e32 %0, %1, %2":"=v"(r):"v"(a),"v"(b));return r;}
typedef float f32x2_t __attribute__((ext_vector_type(2))); typedef __bf16 bf16x2_t __attribute__((ext_vector_type(2)));
__device__ __forceinline__ unsigned cvtpk_s(float lo,float hi){f32x2_t v={lo,hi};bf16x2_t b=__builtin_convertvector(v,bf16x2_t);return __builtin_bit_cast(unsigned,b);}
#define WAIT_BAR(N) asm volatile("s_waitcnt vmcnt(" #N ") lgkmcnt(0)\n\ts_barrier":::"memory")

__device__ __forceinline__ void qkt(f32x16&p0,f32x16&p1,const char*Kslot,const bf16x8*qr,const f32x16&negm,int r32,int hi){
  const char*kb=Kslot+hi*1024+r32*16;
  #pragma unroll
  for(int d0=0;d0<4;++d0){
    const bf16x8 b0=*reinterpret_cast<const bf16x8*>(kb+d0*2048);
    const bf16x8 b1=*reinterpret_cast<const bf16x8*>(kb+d0*2048+512);
    if(d0==0){p0=__builtin_amdgcn_mfma_f32_32x32x16_bf16(b0,qr[0],negm,0,0,0);p1=__builtin_amdgcn_mfma_f32_32x32x16_bf16(b1,qr[0],negm,0,0,0);}
    else{p0=__builtin_amdgcn_mfma_f32_32x32x16_bf16(b0,qr[d0],p0,0,0,0);p1=__builtin_amdgcn_mfma_f32_32x32x16_bf16(b1,qr[d0],p1,0,0,0);}}
}
typedef __attribute__((address_space(3))) const char* lds_cptr;
typedef short v4i16_t __attribute__((ext_vector_type(4)));
__device__ __forceinline__ void kload8(bf16x8*kf,lds_cptr kp){
  kf[0]=*(const __attribute__((address_space(3))) bf16x8*)(kp);      kf[1]=*(const __attribute__((address_space(3))) bf16x8*)(kp+512);
  kf[2]=*(const __attribute__((address_space(3))) bf16x8*)(kp+2048); kf[3]=*(const __attribute__((address_space(3))) bf16x8*)(kp+2560);
  kf[4]=*(const __attribute__((address_space(3))) bf16x8*)(kp+4096); kf[5]=*(const __attribute__((address_space(3))) bf16x8*)(kp+4608);
  kf[6]=*(const __attribute__((address_space(3))) bf16x8*)(kp+6144); kf[7]=*(const __attribute__((address_space(3))) bf16x8*)(kp+6656);
}
__device__ __forceinline__ void kload2(bf16x8*kf,lds_cptr kp,int j){ kf[2*j]=*(const __attribute__((address_space(3))) bf16x8*)(kp+j*2048); kf[2*j+1]=*(const __attribute__((address_space(3))) bf16x8*)(kp+j*2048+512); }
__device__ __forceinline__ s16x4 vtr(lds_cptr p){ return __builtin_bit_cast(s16x4,__builtin_amdgcn_ds_read_tr16_b64_v4i16((__attribute__((address_space(3))) v4i16_t*)p)); }
__device__ __forceinline__ float rowmax(const f32x16&p0,const f32x16&p1){
  float a=max3f(p0[0],p0[1],p1[0]),b=max3f(p0[2],p0[3],p1[1]);a=max3f(a,p1[2],p1[3]);
  #pragma unroll
  for(int r=4;r<16;r+=4){a=max3f(a,p0[r],p0[r+1]);b=max3f(b,p0[r+2],p0[r+3]);a=max3f(a,p1[r],p1[r+1]);b=max3f(b,p1[r+2],p1[r+3]);}
  const float m=max2f(a,b);
  auto rr=__builtin_amdgcn_permlane32_swap(__float_as_uint(m),__float_as_uint(m),false,false);
  return max2f(__uint_as_float(rr[0]),__uint_as_float(rr[1]));
}
__device__ __forceinline__ void pv(f32x16*o,int vb,bf16x8 pa0,bf16x8 pa1,bf16x8 pa2,bf16x8 pa3){
  #pragma unroll
  for(int d0=0;d0<2;++d0){s16x4 lo[4],hi[4];
    #pragma unroll
    for(int ks=0;ks<4;++ks){
      asm volatile("ds_read_b64_tr_b16 %0,%1 offset:%c2":"=&v"(lo[ks]):"v"(vb),"i"(d0*4096+ks*1024):"memory");
      asm volatile("ds_read_b64_tr_b16 %0,%1 offset:%c2":"=&v"(hi[ks]):"v"(vb),"i"(d0*4096+ks*1024+512):"memory");}
    asm volatile("s_waitcnt lgkmcnt(0)":::"memory");SBAR();
    #define PK(k) (bf16x8){lo[k][0],lo[k][1],lo[k][2],lo[k][3],hi[k][0],hi[k][1],hi[k][2],hi[k][3]}
    o[d0]=__builtin_amdgcn_mfma_f32_32x32x16_bf16(pa0,PK(0),o[d0],0,0,0);
    o[d0]=__builtin_amdgcn_mfma_f32_32x32x16_bf16(pa1,PK(1),o[d0],0,0,0);
    o[d0]=__builtin_amdgcn_mfma_f32_32x32x16_bf16(pa2,PK(2),o[d0],0,0,0);
    o[d0]=__builtin_amdgcn_mfma_f32_32x32x16_bf16(pa3,PK(3),o[d0],0,0,0);
    #undef PK
  }
}

#ifndef ATTN_STORE16
#define ATTN_STORE16(p,v) (*(u32x4*)(p)=(v))
#endif
template<int MODE,int THRL> __device__ __forceinline__ void attn_unit(int qb,int t0,const bf16*Q,const bf16*__restrict__ K,const bf16*__restrict__ V,bf16*O,char*shm,const float*ksum,float sinkl2,const unsigned short*list=nullptr,int len=256,float*stat=nullptr){
  int tid_=threadIdx.x; asm volatile("":"+v"(tid_)); const int tid=tid_,lane=tid&63,r32=lane&31,hi=lane>>5; const int wid=__builtin_amdgcn_readfirstlane(tid>>6);
  const int q0=qb*QB;
  const bf16*Qw=Q+(long)(q0+wid*QBLK)*DM;
  const bf16*Kh=K+(long)t0*KVBLK*DM,*Vh=V+(long)t0*KVBLK*DM;
  const unsigned lds0=(unsigned)(uintptr_t)shm;
  float*wsf=(float*)(shm+LDS_WS)+wid*64;
  const bf16*ksrc=Kh+(long)lane*DM+wid*8;
  const bf16*vsrc=Vh+(long)(16*(wid&3)+(lane>>2))*DM+(wid>>2)*32+(lane&3)*8;
  const unsigned kdst=lds0+LDS_K+wid*1024, vdst=lds0+LDS_V+wid*1024;
  #define DMA_K(t,slot) glds16(ksrc+(long)(t)*KVBLK*DM,(unsigned)__builtin_amdgcn_readfirstlane(kdst+(slot)))
  #define DMA_V(t,slot) glds16(vsrc+(long)(t)*KVBLK*DM,(unsigned)__builtin_amdgcn_readfirstlane(vdst+(slot)))
  const int vb0=(int)(lds0+LDS_V)+((lane>>4)&1)*32+(lane&3)*8+(4*hi+((lane&15)>>2))*64;
  const char*Kbase=shm+LDS_K; bf16x8 kf[8];
  const lds_cptr shm3=(lds_cptr)shm; const lds_cptr kp0=shm3+LDS_K+hi*1024+r32*16; const lds_cptr vp0=shm3+LDS_V+((lane>>4)&1)*32+(lane&3)*8+(4*hi+((lane&15)>>2))*64;
  const int NT=(q0+QB)/KVBLK-t0;
  bf16x8 qr[4]; unsigned long long sel=0ull;
  const bf16*Qrow=Qw+(long)r32*DM;
  if(MODE==3){ const int p_=wid*QBLK+r32; const long trow_=list?(long)list[p_<len?p_:len-1]:(long)(q0+p_); Qrow=Q+trow_*DM; }
  if(MODE==1){
    #pragma unroll
    for(int d0=0;d0<4;++d0)qr[d0]=*reinterpret_cast<const bf16x8*>(&Qrow[d0*16+hi*8]);
    float*km=(float*)(shm+86016);
    #pragma unroll
    for(int i=0;i<8;++i){const int e=tid+512*i; km[e]=(ksum[e]+ksum[e+4*64*64])*(1.0f/256.0f);}
    asm volatile("s_waitcnt vmcnt(0) lgkmcnt(0)\n\ts_barrier":::"memory");
    float qf[32];
    #pragma unroll
    for(int d0=0;d0<4;++d0)
      #pragma unroll
      for(int j=0;j<8;++j)qf[d0*8+j]=__uint_as_float(((unsigned)(unsigned short)qr[d0][j])<<16);
    float t1=-INFINITY,t2=-INFINITY,t3=-INFINITY; int i1=-1,i2=-1,i3=-1;
    for(int b=0;b<qb;++b){
      const float*kr=km+b*64+hi*8; float g=0.f;
      #pragma unroll
      for(int d0=0;d0<4;++d0)
        #pragma unroll
        for(int j=0;j<8;++j)g+=qf[d0*8+j]*kr[d0*16+j];
      g+=__shfl_xor(g,32);
      if(g>t3){ if(g>t2){ t3=t2;i3=i2; if(g>t1){t2=t1;i2=i1;t1=g;i1=b;} else {t2=g;i2=b;} } else {t3=g;i3=b;} }
    }
    if(i1>=0)sel|=1ull<<i1; if(i2>=0)sel|=1ull<<i2; if(i3>=0)sel|=1ull<<i3;
  }
  DMA_K(0,0);DMA_V(0,0);DMA_K(1,SLOTB);
  if(MODE!=1){
    #pragma unroll
    for(int d0=0;d0<4;++d0)qr[d0]=*reinterpret_cast<const bf16x8*>(&Qrow[d0*16+hi*8]);
  }
  float mhat=0.f,l_reg=0.f;f32x16 o[2];o[0]=f32x16{};o[1]=f32x16{};f32x16 negm=f32x16{};asm volatile("":"+v"(negm));
  const int qrel=wid*QBLK+r32;
  #define CMASK(P0,P1,t) do{int jb_=(t)-(NT-4); if(MODE==3){ if(!list&&jb_>=0)cmask(P0,P1,jb_,qrel,hi); } else if(MODE==2){swamask(P0,P1,jb_,qrel,hi);} else if(jb_>=0){cmask(P0,P1,jb_,qrel,hi);} else if(MODE==1){mobamask(P0,P1,sel,(t)>>2);} }while(0)
  bool resc=false;
  #define START(P0,P1) do{ const float rm=rowmax(P0,P1); resc=false; \
    { const float dl=rm; mhat=fadd_s(mhat,dl); \
      _Pragma("unroll") for(int r=0;r<16;++r){P0[r]=fsub_s(P0[r],dl);P1[r]=fsub_s(P1[r],dl);} \
      _Pragma("unroll") for(int r=0;r<16;++r)negm[r]=-mhat; asm volatile("":"+v"(negm)); } \
    _Pragma("unroll") for(int r=0;r<16;++r)P0[r]=__builtin_amdgcn_exp2f(P0[r]); }while(0)
  #define RESC() do{ if(resc){ asm volatile("s_waitcnt lgkmcnt(0)":::"memory"); \
      _Pragma("unroll") for(int d_=0;d_<2;++d_) _Pragma("unroll") for(int r=0;r<16;++r)o[d_][r]*=wsf[crow(r,hi)]; } }while(0)
  f32x16 pA0,pA1,pB0,pB1;
  int sl_prev=0,sl_cur=0,sl_next=SLOTB;
  #define ROT() do{sl_prev=sl_cur;sl_cur=sl_next;sl_next=(sl_next==(NSLOT-1)*SLOTB)?0:sl_next+SLOTB;}while(0)
  DMA_K(2,2*SLOTB);
  WAIT_BAR(3);
  qkt(pA0,pA1,Kbase,qr,negm,r32,hi);asm volatile("s_nop 15\n\ts_nop 7":"+v"(pA0),"+v"(pA1));CMASK(pA0,pA1,0);
  START(pA0,pA1);
  _Pragma("unroll") for(int r=0;r<16;++r)pA1[r]=__builtin_amdgcn_exp2f(pA1[r]);
  WAIT_BAR(0);
  DMA_K(3,0);DMA_V(1,SLOTB);
  ROT();
  kload8(kf,kp0+sl_cur);
  WAIT_BAR(2);
  s16x4 vlo[8],vhi[8]; u32x4 pw0,pw1,pw2,pw3;
  #define PKW(P,B) cvtpk_s(P[B],P[B+1])
  #define PAF(k) __builtin_bit_cast(bf16x8,pw##k)
  #define VFR(i) (bf16x8){vlo[i][0],vlo[i][1],vlo[i][2],vlo[i][3],vhi[i][0],vhi[i][1],vhi[i][2],vhi[i][3]}
  #define PIN(x) asm volatile("":"+v"(x))
  #define MX3(a,b,c) __builtin_fmaxf(__builtin_fmaxf((a),(b)),(c))
  #define GAPA(MF,A0,A1,A2,A3,W0,W1,PW) do{ MF; sacc+=A0; sacc+=A1; sacc+=A2; sacc+=A3; PIN(sacc); W0; W1; PIN(PW); SBAR(); }while(0)
  #define EX(v) __builtin_amdgcn_exp2f(v)
  #define GAPB(MF,X,B) do{ MF; X[B]=EX(X[B]); X[B+1]=EX(X[B+1]); X[B+2]=EX(X[B+2]); X[B+3]=EX(X[B+3]); PIN(X); SBAR(); }while(0)
  #define VRD(i) do{ vlo[i]=vtr(vp_+(((i)>>2)*4096+((i)&3)*1024)); vhi[i]=vtr(vp_+(((i)>>2)*4096+((i)&3)*1024+512)); }while(0)
  #define KRD(G,j) do{ if(G){ kload2(kf,kp0+sl_next,j); SBAR(); } }while(0)
  #define STEP(C0,C1,P0,P1,t,GK,GV,GL) do{ SBAR(); \
    const lds_cptr vp_=vp0+sl_prev; \
    VRD(0); SBAR(); float sacc=(P0[0]+P0[1]); \
    GAPA(C0=__builtin_amdgcn_mfma_f32_32x32x16_bf16(kf[0],qr[0],negm,0,0,0), P0[2],P0[3],P0[4],P0[5],     pw0[0]=PKW(P0,0), pw0[1]=PKW(P0,2), pw0); \
    VRD(4); SBAR(); GAPA(C1=__builtin_amdgcn_mfma_f32_32x32x16_bf16(kf[1],qr[0],negm,0,0,0), P0[6],P0[7],P0[8],P0[9],     pw0[2]=PKW(P0,4), pw0[3]=PKW(P0,6), pw0); \
    VRD(1); SBAR(); GAPA(C0=__builtin_amdgcn_mfma_f32_32x32x16_bf16(kf[2],qr[1],C0,0,0,0),   P0[10],P0[11],P0[12],P0[13], pw1[0]=PKW(P0,8), pw1[1]=PKW(P0,10), pw1); \
    VRD(5); SBAR(); GAPA(C1=__builtin_amdgcn_mfma_f32_32x32x16_bf16(kf[3],qr[1],C1,0,0,0),   P0[14],P0[15],P1[0],P1[1],   pw1[2]=PKW(P0,12),pw1[3]=PKW(P0,14), pw1); \
    VRD(2); SBAR(); GAPA(C0=__builtin_amdgcn_mfma_f32_32x32x16_bf16(kf[4],qr[2],C0,0,0,0),   P1[2],P1[3],P1[4],P1[5],     pw2[0]=PKW(P1,0), pw2[1]=PKW(P1,2), pw2); \
    VRD(6); SBAR(); GAPA(C1=__builtin_amdgcn_mfma_f32_32x32x16_bf16(kf[5],qr[2],C1,0,0,0),   P1[6],P1[7],P1[8],P1[9],     pw2[2]=PKW(P1,4), pw2[3]=PKW(P1,6), pw2); \
    VRD(3); SBAR(); GAPA(C0=__builtin_amdgcn_mfma_f32_32x32x16_bf16(kf[6],qr[3],C0,0,0,0),   P1[10],P1[11],P1[12],P1[13], pw3[0]=PKW(P1,8), pw3[1]=PKW(P1,10), pw3); \
    VRD(7); SBAR(); GAPA(C1=__builtin_amdgcn_mfma_f32_32x32x16_bf16(kf[7],qr[3],C1,0,0,0),   P1[14],P1[15],0.f,0.f,       pw3[2]=PKW(P1,12),pw3[3]=PKW(P1,14), pw3); \
    l_reg+=sacc; \
    if(GK){DMA_K((t)+3,sl_cur);} if(GV){DMA_V((t)+1,sl_next);} \
    CMASK(C0,C1,t); \
    { float a=MX3(C0[0],C0[1],C1[0]),b=MX3(C0[2],C0[3],C1[1]); a=MX3(a,C1[2],C1[3]); \
      _Pragma("unroll") for(int r=4;r<16;r+=4){a=MX3(a,C0[r],C0[r+1]);b=MX3(b,C0[r+2],C0[r+3]);a=MX3(a,C1[r],C1[r+1]);b=MX3(b,C1[r+2],C1[r+3]);} \
      float rm=__builtin_fmaxf(a,b); { auto rr=__builtin_amdgcn_permlane32_swap(__float_as_uint(rm),__float_as_uint(rm),false,false); rm=__builtin_fmaxf(__uint_as_float(rr[0]),__uint_as_float(rr[1])); } \
      resc=false; \
      if(__builtin_expect(__any(rm>(float)THRL),0)){ const float dl=__builtin_fmaxf(rm,0.f); mhat+=dl; \
        _Pragma("unroll") for(int r=0;r<16;++r){C0[r]-=dl;C1[r]-=dl;} \
        _Pragma("unroll") for(int r=0;r<16;++r)negm[r]=-mhat; asm volatile("":"+v"(negm)); \
        const float f=__builtin_amdgcn_exp2f(-dl); l_reg*=f; if(hi==0)wsf[r32]=f; resc=true; } } \
    SBAR(); \
    GAPB(o[0]=__builtin_amdgcn_mfma_f32_32x32x16_bf16(PAF(0),VFR(0),o[0],0,0,0), C0,0); \
    GAPB(o[1]=__builtin_amdgcn_mfma_f32_32x32x16_bf16(PAF(0),VFR(4),o[1],0,0,0), C0,4); \
    KRD(GL,0); GAPB(o[0]=__builtin_amdgcn_mfma_f32_32x32x16_bf16(PAF(1),VFR(1),o[0],0,0,0), C0,8); \
    KRD(GL,1); GAPB(o[1]=__builtin_amdgcn_mfma_f32_32x32x16_bf16(PAF(1),VFR(5),o[1],0,0,0), C0,12); \
    KRD(GL,2); GAPB(o[0]=__builtin_amdgcn_mfma_f32_32x32x16_bf16(PAF(2),VFR(2),o[0],0,0,0), C1,0); \
    KRD(GL,3); GAPB(o[1]=__builtin_amdgcn_mfma_f32_32x32x16_bf16(PAF(2),VFR(6),o[1],0,0,0), C1,4); \
    GAPB(o[0]=__builtin_amdgcn_mfma_f32_32x32x16_bf16(PAF(3),VFR(3),o[0],0,0,0), C1,8); \
    GAPB(o[1]=__builtin_amdgcn_mfma_f32_32x32x16_bf16(PAF(3),VFR(7),o[1],0,0,0), C1,12); \
    }while(0)
  int t=1;
  #undef CMASK
  #define CMASK(P0,P1,t) do{ if(MODE==1){mobamask(P0,P1,sel,(t)>>2);} }while(0)
  for(;t+5<NT;t+=2){
    STEP(pB0,pB1,pA0,pA1,t,true,true,true);     WAIT_BAR(2); RESC(); ROT();
    STEP(pA0,pA1,pB0,pB1,t+1,true,true,true);   WAIT_BAR(2); RESC(); ROT();
  }
  #undef CMASK
  #define CMASK(P0,P1,t) do{int jb_=(t)-(NT-4); if(MODE==3){ if(!list&&jb_>=0)cmask(P0,P1,jb_,qrel,hi); } else if(MODE==2){swamask(P0,P1,jb_,qrel,hi);} else if(jb_>=0){cmask(P0,P1,jb_,qrel,hi);} else if(MODE==1){mobamask(P0,P1,sel,(t)>>2);} }while(0)
  #define ENDW(tt) do{ if((tt)+3<NT){WAIT_BAR(2);} else if((tt)+2<NT){WAIT_BAR(1);} else {WAIT_BAR(0);} }while(0)
  for(;t+1<NT;t+=2){
    STEP(pB0,pB1,pA0,pA1,t,(t+3<NT),(t+1<NT),(t+1<NT));       ENDW(t);   RESC(); ROT();
    STEP(pA0,pA1,pB0,pB1,t+1,(t+4<NT),(t+2<NT),(t+2<NT));     ENDW(t+1); RESC(); ROT();
  }
  STEP(pB0,pB1,pA0,pA1,NT-1,false,false,false); RESC();
  { float sacc=pB0[0]+pB0[1]; _Pragma("unroll") for(int r=2;r<16;++r)sacc+=pB0[r]; _Pragma("unroll") for(int r=0;r<16;++r)sacc+=pB1[r]; l_reg+=sacc;
    pw0=(u32x4){PKW(pB0,0),PKW(pB0,2),PKW(pB0,4),PKW(pB0,6)};pw1=(u32x4){PKW(pB0,8),PKW(pB0,10),PKW(pB0,12),PKW(pB0,14)};pw2=(u32x4){PKW(pB1,0),PKW(pB1,2),PKW(pB1,4),PKW(pB1,6)};pw3=(u32x4){PKW(pB1,8),PKW(pB1,10),PKW(pB1,12),PKW(pB1,14)};
    SBAR(); pv(o,vb0+sl_cur,PAF(0),PAF(1),PAF(2),PAF(3)); }
  #undef PKW
  #undef PAF
  #undef VFR
  #undef PIN
  #undef MX3
  #undef GAPA
  #undef GAPB
  #undef EX
  #undef VRD
  #undef KRD
  #undef STEP
  #undef ENDW
  {auto rr=__builtin_amdgcn_permlane32_swap(__float_as_uint(l_reg),__float_as_uint(l_reg),false,false);l_reg=__uint_as_float(rr[0])+__uint_as_float(rr[1]);}
  if(MODE==2)l_reg+=__builtin_amdgcn_exp2f(sinkl2-mhat);
  if(MODE==3){ const int p_=wid*QBLK+r32; if(hi==0&&p_<len)stat[p_]=mhat+__builtin_amdgcn_logf(l_reg); }
  if(hi==0)wsf[32+r32]=l_reg;asm volatile("s_waitcnt lgkmcnt(0)":::"memory");
  float rli[16];
  #pragma unroll
  for(int r=0;r<16;++r)rli[r]=__builtin_amdgcn_rcpf(wsf[32+crow(r,hi)]);
  constexpr int OP_=(MODE==3)?64:OPITCH; bf16*Ow=(MODE==3)?O+(long)(wid*QBLK)*OP_:O+(long)(q0+wid*QBLK)*OP_;
  { bf16*stg=(bf16*)(shm+LDS_OST)+wid*2048;
    #pragma unroll
    for(int r=0;r<16;++r){const int orow=crow(r,hi);
      #pragma unroll
      for(int d0=0;d0<2;++d0)stg[orow*64+d0*32+r32]=__float2bfloat16(o[d0][r]*rli[r]);}
    asm volatile("s_waitcnt lgkmcnt(0)":::"memory");
    #pragma unroll
    for(int i=0;i<4;++i){const int row=i*8+(lane>>3),ch=lane&7; const u32x4 v=*(const u32x4*)(stg+row*64+ch*8); if(MODE!=3||wid*QBLK+row<len)ATTN_STORE16(Ow+(long)row*OP_+ch*8,v);} }
  asm volatile("s_waitcnt lgkmcnt(0)\n\ts_barrier":::"memory");
  #undef DMA_K
  #undef DMA_V
  #undef CMASK
  #undef START
  #undef RESC
  #undef ROT
}

#define MG_BETTER(g,b,t,i) ((g)>(t)||((g)==(t)&&(b)<(i)))
#define MG_INS(g,b) do{ if(MG_BETTER(g,b,t3,i3)){ if(MG_BETTER(g,b,t2,i2)){ t3=t2;i3=i2; if(MG_BETTER(g,b,t1,i1)){t2=t1;i2=i1;t1=(g);i1=(b);} else {t2=(g);i2=(b);} } else {t3=(g);i3=(b);} } }while(0)
__device__ __forceinline__ void moba_gate(int qb,const bf16*Q,char*shm,const float*ksum,unsigned*cnt,int*seltmp){
  typedef __attribute__((address_space(3))) int* lds_iptr;
  int tid_=threadIdx.x; asm volatile("":"+v"(tid_)); const int tid=tid_,lane=tid&63,r32=lane&31,hi=lane>>5; const int wid=__builtin_amdgcn_readfirstlane(tid>>6);
  const int t=qb*QB+wid*QBLK+r32; const bf16*Qrow=Q+(long)t*DM; bf16x8 qr[4];
  #pragma unroll
  for(int d0=0;d0<4;++d0)qr[d0]=*reinterpret_cast<const bf16x8*>(&Qrow[d0*16+hi*8]);
  unsigned short*kt=(unsigned short*)(shm+LDS_K);
  const lds_iptr hist=(lds_iptr)((lds_cptr)shm+102400);
  #pragma unroll
  for(int i=0;i<8;++i){const int e=tid+512*i,b=e>>6,d=e&63; const float m=(ksum[e]+ksum[e+4*64*64])*(1.0f/256.0f); kt[(d>>3)*512+b*8+(d&7)]=__builtin_bit_cast(unsigned short,__float2bfloat16(m));}
  if(tid<64)hist[tid]=0;
  asm volatile("s_waitcnt vmcnt(0) lgkmcnt(0)\n\ts_barrier":::"memory");
  f32x16 g0,g1; { const f32x16 z=f32x16{}; qkt(g0,g1,shm+LDS_K,qr,z,r32,hi); }
  float t1=-INFINITY,t2=-INFINITY,t3=-INFINITY; int i1=1<<20,i2=1<<20,i3=1<<20;
  #pragma unroll
  for(int r=0;r<16;++r){ const int b=crow(r,hi); const float ga=(b<qb)?g0[r]:-INFINITY, gb=(b+32<qb)?g1[r]:-INFINITY; MG_INS(ga,b); MG_INS(gb,b+32); }
  { const float u1=__shfl_xor(t1,32),u2=__shfl_xor(t2,32),u3=__shfl_xor(t3,32); const int j1=__shfl_xor(i1,32),j2=__shfl_xor(i2,32),j3=__shfl_xor(i3,32);
    MG_INS(u1,j1); MG_INS(u2,j2); MG_INS(u3,j3); }
  if(!(t1>-INFINITY))i1=-1; if(!(t2>-INFINITY))i2=-1; if(!(t3>-INFINITY))i3=-1;
  int k1=0,k2=0,k3=0;
  if(hi==0){ if(i1>=0)k1=__hip_atomic_fetch_add(hist+i1,1,__ATOMIC_RELAXED,__HIP_MEMORY_SCOPE_WORKGROUP);
             if(i2>=0)k2=__hip_atomic_fetch_add(hist+i2,1,__ATOMIC_RELAXED,__HIP_MEMORY_SCOPE_WORKGROUP);
             if(i3>=0)k3=__hip_atomic_fetch_add(hist+i3,1,__ATOMIC_RELAXED,__HIP_MEMORY_SCOPE_WORKGROUP); }
  asm volatile("s_waitcnt vmcnt(0) lgkmcnt(0)\n\ts_barrier":::"memory");
  if(tid<64){ const int n=hist[tid]; hist[64+tid]=n>0?(int)atomicAdd(cnt+tid,(unsigned)n):0; }
  asm volatile("s_waitcnt vmcnt(0) lgkmcnt(0)\n\ts_barrier":::"memory");
  if(hi==0){ int v1=-1,v2=-1,v3=-1;
    if(i1>=0)v1=(i1<<16)|(hist[64+i1]+k1);
    if(i2>=0)v2=(i2<<16)|(hist[64+i2]+k2);
    if(i3>=0)v3=(i3<<16)|(hist[64+i3]+k3);
    seltmp[(long)t*4+0]=v1; seltmp[(long)t*4+1]=v2; seltmp[(long)t*4+2]=v3; }
  asm volatile("s_waitcnt vmcnt(0) lgkmcnt(0)\n\ts_barrier":::"memory");
}
#undef MG_INS
#undef MG_BETTER
constexpr int ATTN_LDS_BYTES=LDS_BYTES;
#undef SBAR
#undef WAIT_BAR
}

namespace cg = cooperative_groups;
constexpr int NWAVES = 8;
constexpr int M = 16384, DMODEL = 1024, DFF = 2816, QKVW = 2816, OPW = 1536;
constexpr size_t MiB = 1u << 20;
constexpr size_t WS_BAR = 512 * 1024;
constexpr size_t WS_CTL = 0;
constexpr size_t WS_SSQ = 244 * MiB;
constexpr size_t WS_KSUM = 2 * MiB;
constexpr size_t WS_COS = 3 * MiB, WS_SIN = 5 * MiB;
constexpr size_t WS_W = 8 * MiB;
constexpr size_t W_GU1 = 0, W_D1 = W_GU1 + (size_t)5632 * 1024 * 2, W_QKV = W_D1 + (size_t)1024 * 2816 * 2, W_G = W_QKV + (size_t)2816 * 1024 * 2,
                 W_BA = W_G + (size_t)3 * 1024 * 1024 * 2, W_BB = W_BA + (size_t)1024 * 256 * 2, W_BC = W_BB + (size_t)1024 * 256 * 2, W_O = W_BC + (size_t)1024 * 512 * 2,
                 W_GU2 = W_O + (size_t)1024 * 1024 * 2, W_D2 = W_GU2 + (size_t)5632 * 1024 * 2, W_END = W_D2 + (size_t)1024 * 2816 * 2;
static_assert(W_END <= 52 * MiB, "weights");
constexpr size_t WS_XB = 60 * MiB;
constexpr size_t WS_R1 = 92 * MiB;
constexpr size_t WS_OB = 180 * MiB;
constexpr size_t WS_OC = 228 * MiB;
constexpr size_t WS_OCN = WS_R1 + 64 * MiB;
constexpr size_t WS_MSTAT = 252 * MiB;
constexpr size_t WS_MSEL = 253 * MiB;
constexpr size_t WS_MLIST = 254 * MiB;
constexpr size_t WS_END = 255 * MiB;
constexpr int RING_BYTES = 131072, MISC_OFF = RING_BYTES, LDS_BYTES = 147456;
constexpr int KM_OFF = 86016;
static_assert(attn_body::ATTN_LDS_BYTES <= KM_OFF && KM_OFF + 16384 <= RING_BYTES, "lds map");

#define LAS __attribute__((address_space(3)))
typedef unsigned short bf16;
typedef unsigned v4u __attribute__((ext_vector_type(4)));
typedef float f32x4 __attribute__((ext_vector_type(4)));
#define LDS_WAIT() asm volatile("s_waitcnt lgkmcnt(0)" ::: "memory")
__device__ __forceinline__ unsigned f2bf(float f) { unsigned u = __builtin_bit_cast(unsigned, f); return (u + 0x7fffu + ((u >> 16) & 1u)) >> 16; }
__device__ __forceinline__ unsigned pk2(float lo, float hi) { return f2bf(lo) | (f2bf(hi) << 16); }
__device__ __forceinline__ float wave_sum(float v) {
#pragma unroll
    for (int o = 1; o < 64; o <<= 1) v += __shfl_xor(v, o);
    return v;
}

__device__ __forceinline__ void conv_item(const float* W, int ldw, int col0, int ncols, int K, const float* gain, int mode, int bsel, bf16* WT, LAS float* scr, int item, int lane) {
    const int nblk = ncols / 32, kb = item / nblk, nb = item % nblk, k0 = 64 * kb, n0 = col0 + 32 * nb;
    { float wv[32]; const float* wp = W + (size_t)(k0 + (lane >> 5)) * ldw + n0 + (lane & 31);
#pragma unroll
      for (int i = 0; i < 32; ++i) wv[i] = __builtin_nontemporal_load(&wp[(size_t)(2 * i) * ldw]);
      if (gain) {
#pragma unroll
          for (int i = 0; i < 32; ++i) wv[i] *= gain[k0 + 2 * i + (lane >> 5)]; }
#pragma unroll
      for (int i = 0; i < 32; ++i) scr[(2 * i + (lane >> 5)) * 33 + (lane & 31)] = wv[i]; }
    LDS_WAIT(); asm volatile("" ::: "memory");
    int pbase;
    if (mode == 0) pbase = 32 * nb; else if (mode == 1) pbase = 256 * (nb >> 3) + 128 * (nb & 1) + 32 * ((nb >> 1) & 3); else pbase = 256 * (nb >> 2) + 128 * bsel + 32 * (nb & 3);
    const int c = lane & 7;
#pragma unroll
    for (int j = 0; j < 4; ++j) { const int n = (lane >> 3) + 8 * j; const LAS float* s = scr + (8 * c) * 33 + n;
        const int prow = pbase + 16 * ((n >> 2) & 1) + 4 * (n >> 3) + (n & 3);
        v4u o; o.x = pk2(s[0 * 33], s[1 * 33]); o.y = pk2(s[2 * 33], s[3 * 33]); o.z = pk2(s[4 * 33], s[5 * 33]); o.w = pk2(s[6 * 33], s[7 * 33]);
        *(v4u*)(WT + (size_t)prow * K + k0 + 8 * c) = o; }
    LDS_WAIT(); asm volatile("" ::: "memory");
}

struct Args { const float* in[27]; float* out; unsigned char* ws; };

template <class ArgsRef> __device__ __forceinline__ void conv_layer(const ArgsRef& a, int l, unsigned char* wsb, LAS float* scr, int gw, int NGW, int lane, int mi_lo, int mi_hi) {
    bf16* WB = (bf16*)(wsb + WS_W);
#pragma nounroll
    for (int mi = mi_lo; mi < mi_hi; ++mi) {
        const float* W; int ldw, col0 = 0, ncols, K, mode = 0, bsel = 0; const float* gain = nullptr; size_t dst;
        switch (mi) {
            case 0: W = a.in[2] + (size_t)l * 1024 * 2816; ldw = 2816; ncols = 2816; K = 1024; gain = a.in[1] + l * 1024; mode = 2; bsel = 0; dst = W_GU1; break;
            case 1: W = a.in[3] + (size_t)l * 1024 * 2816; ldw = 2816; ncols = 2816; K = 1024; gain = a.in[1] + l * 1024; mode = 2; bsel = 1; dst = W_GU1; break;
            case 2: W = a.in[4] + (size_t)l * 2816 * 1024; ldw = 1024; ncols = 1024; K = 2816; dst = W_D1; break;
            case 3: W = a.in[6] + (size_t)l * 1024 * 5888; ldw = 5888; ncols = 2816; K = 1024; gain = a.in[5] + l * 1024; mode = 1; dst = W_QKV; break;
            case 4: W = a.in[6] + (size_t)l * 1024 * 5888; ldw = 5888; col0 = 2816; ncols = 1024; K = 1024; gain = a.in[5] + l * 1024; dst = W_G; break;
            case 5: W = a.in[6] + (size_t)l * 1024 * 5888; ldw = 5888; col0 = 3840; ncols = 1024; K = 1024; gain = a.in[5] + l * 1024; dst = W_G + (size_t)1024 * 1024 * 2; break;
            case 6: W = a.in[6] + (size_t)l * 1024 * 5888; ldw = 5888; col0 = 4864; ncols = 1024; K = 1024; gain = a.in[5] + l * 1024; dst = W_G + (size_t)2 * 1024 * 1024 * 2; break;
            case 7: W = a.in[19] + (size_t)l * 256 * 1024; ldw = 1024; ncols = 1024; K = 256; dst = W_BA; break;
            case 8: W = a.in[20] + (size_t)l * 256 * 1024; ldw = 1024; ncols = 1024; K = 256; dst = W_BB; break;
            case 9: W = a.in[21] + (size_t)l * 512 * 1024; ldw = 1024; ncols = 1024; K = 512; dst = W_BC; break;
            case 10: W = a.in[22] + (size_t)l * 1024 * 1024; ldw = 1024; ncols = 1024; K = 1024; dst = W_O; break;
            case 11: W = a.in[24] + (size_t)l * 1024 * 2816; ldw = 2816; ncols = 2816; K = 1024; gain = a.in[23] + l * 1024; mode = 2; bsel = 0; dst = W_GU2; break;
            case 12: W = a.in[25] + (size_t)l * 1024 * 2816; ldw = 2816; ncols = 2816; K = 1024; gain = a.in[23] + l * 1024; mode = 2; bsel = 1; dst = W_GU2; break;
            default: W = a.in[26] + (size_t)l * 2816 * 1024; ldw = 1024; ncols = 1024; K = 2816; dst = W_D2; break;
        }
        const int nitems = (K / 64) * (ncols / 32);
        bf16* WT = (bf16*)((unsigned char*)WB + dst);
        for (int it = gw; it < nitems; it += NGW) conv_item(W, ldw, col0, ncols, K, gain, mode, bsel, WT, scr, it, lane);
    }
}

constexpr int N_HEAVY = 64 * 20, N_UNITS = N_HEAVY + 256;
constexpr float LOG2E = 1.4426950408889634f;

#define XB_TMO      128
#define XB_XCNT(j)  (256  + 64 * (j))
#define XB_XSUB(j)  (1280 + 64 * (j))
#define XB_XGEN(j)  (2304 + 64 * (j))
#define XB_TOP      3328
#define XB_TOPGEN   3392
#define XCD_BAR_WORDS 3456
#define XB_SPIN_CAP (1u << 18)

__device__ __forceinline__ unsigned xb_ld(unsigned* p)              { return __hip_atomic_load(p, __ATOMIC_RELAXED, __HIP_MEMORY_SCOPE_AGENT); }
__device__ __forceinline__ unsigned xb_add(unsigned* p, unsigned v) { return __hip_atomic_fetch_add(p, v, __ATOMIC_RELAXED, __HIP_MEMORY_SCOPE_AGENT); }
__device__ __forceinline__ unsigned xb_xcc_id() { return (unsigned)__builtin_amdgcn_s_getreg((3 << 11) | 20) & 0xFu; }
#define XB_SPIN(cond, bar) do { unsigned _sp = 0; while (cond) { __builtin_amdgcn_s_sleep(1); \
    if ((++_sp & 255u) == 0u) { if (xb_ld(&(bar)[XB_TMO])) break; if (_sp > XB_SPIN_CAP) { atomicAdd(&(bar)[XB_TMO], 1u); break; } } } } while (0)

struct XcdBarrier {
    unsigned* bar; unsigned x;
    volatile LAS unsigned* st;
};

__device__ __forceinline__ XcdBarrier xcd_barrier_post(unsigned* bar, volatile LAS unsigned* st) {
    XcdBarrier b; b.bar = bar; b.x = xb_xcc_id(); b.st = st;
    if (threadIdx.x == 0) (void)xb_add(&bar[XB_XCNT(b.x)], 1u);
    return b;
}
__device__ __forceinline__ void xcd_barrier_complete(unsigned* bar, unsigned x, unsigned& nloc, unsigned& nx) {
    const unsigned G = gridDim.x * gridDim.y * gridDim.z;
    unsigned sum, cnt, mine, sp = 0u;
    for (;;) {
        sum = 0u; cnt = 0u; mine = 0u;
#pragma unroll
        for (unsigned j = 0; j < 16; ++j) { const unsigned c = xb_ld(&bar[XB_XCNT(j)]); sum += c; cnt += (c > 0u) ? 1u : 0u; mine = (j == x) ? c : mine; }
        if (sum == G) break;
        __builtin_amdgcn_s_sleep(1);
        if ((++sp & 255u) == 0u) { if (xb_ld(&bar[XB_TMO])) break; if (sp > XB_SPIN_CAP) { atomicAdd(&bar[XB_TMO], 1u); break; } }
    }
    nloc = mine > 0u ? mine : 1u; nx = cnt > 0u ? cnt : 1u;
}

__device__ __forceinline__ void xcd_barrier(const XcdBarrier& b) {
    asm volatile("s_waitcnt vmcnt(0)" ::: "memory");
    __syncthreads();
    if (threadIdx.x == 0) {
        unsigned* bar = b.bar;
        __builtin_amdgcn_s_waitcnt(0);
        unsigned nloc = b.st[0], nx = b.st[1];
        if (nloc == 0u) { xcd_barrier_complete(bar, b.x, nloc, nx); b.st[0] = nloc; b.st[1] = nx; }
        const unsigned old = xb_add(&bar[XB_XSUB(b.x)], 1u);
        const unsigned gen = old / nloc;
        if (old + 1u == (gen + 1u) * nloc) {
            __builtin_amdgcn_fence(__ATOMIC_RELEASE, "agent");
            asm volatile("s_waitcnt vmcnt(0)" ::: "memory");
            const unsigned og = xb_add(&bar[XB_TOP], 1u);
            const unsigned tg = og / nx;
            if (og + 1u == (tg + 1u) * nx) xb_add(&bar[XB_TOPGEN], 1u);
            else XB_SPIN(xb_ld(&bar[XB_TOPGEN]) == tg, bar);
            __builtin_amdgcn_fence(__ATOMIC_ACQUIRE, "agent");
            xb_add(&bar[XB_XGEN(b.x)], 1u);
            asm volatile("s_waitcnt vmcnt(0)" ::: "memory");
        } else {
            XB_SPIN(xb_ld(&bar[XB_XGEN(b.x)]) == gen, bar);
            __builtin_amdgcn_fence(__ATOMIC_ACQUIRE, "agent");
            asm volatile("s_waitcnt vmcnt(0)" ::: "memory");
        }
    }
    __syncthreads();
}

__device__ __forceinline__ int opaque_tid() { int t = threadIdx.x; asm volatile("" : "+v"(t)); return t; }
#define GRID_SYNC() do { XcdBarrier xb_; xb_.bar = (unsigned*)(ARGS().ws + WS_BAR); xb_.x = xb_xcc_id(); xb_.st = (volatile LAS unsigned*)(ldsl + MISC_OFF) + 8; xcd_barrier(xb_); } while (0)
__device__ __forceinline__ int opaque_s(int v) { asm volatile("" : "+s"(v)); return v; }
typedef const __attribute__((address_space(4))) Args* KArgsPtr;
__device__ __forceinline__ KArgsPtr opaque_kargs() { KArgsPtr p = (KArgsPtr)__builtin_amdgcn_kernarg_segment_ptr(); asm volatile("" : "+s"(p)); return p; }
#define ARGS() (*opaque_kargs())
#define WSPTR() ({ unsigned char* w_ = ARGS().ws; asm volatile("" : "+s"(w_)); w_; })
__global__ void __launch_bounds__(NWAVES * 64, 2) mega_fwd(Args args_) {
    extern __shared__ __attribute__((aligned(16))) unsigned char lds[];
    cg::grid_group grid = cg::this_grid();
    LAS unsigned char* ldsl = (LAS unsigned char*)lds;
    if (threadIdx.x == 0) { volatile LAS unsigned* mq0_ = (volatile LAS unsigned*)(ldsl + MISC_OFF); mq0_[8] = 0u; mq0_[9] = 0u; }
    __syncthreads();
    (void)xcd_barrier_post((unsigned*)(ARGS().ws + WS_BAR), (volatile LAS unsigned*)(ldsl + MISC_OFF) + 8);
    grid.sync();
    const int G0 = gridDim.x, bx0 = blockIdx.x;
#define G opaque_s(G0)
#define bx opaque_s(bx0)

    {
        unsigned char* ws = WSPTR();
        const int tid = opaque_tid(), lane = tid & 63, wave = __builtin_amdgcn_readfirstlane(tid >> 6);
        const int gw = bx * NWAVES + wave, NGW = G * NWAVES;
        unsigned* ctl = (unsigned*)(ws + WS_CTL); float* ssq = (float*)(ws + WS_SSQ);
        float* cosT = (float*)(ws + WS_COS); float* sinT = (float*)(ws + WS_SIN);
        bf16* XB = (bf16*)(ws + WS_XB);
        if (bx == 0) for (int i = tid; i < 4096; i += NWAVES * 64) ctl[i] = 0u;
        for (int i = bx * (NWAVES * 64) + tid; i < M * 32; i += G * NWAVES * 64) {
            const int pos = i >> 5, fi = i & 31;
            const float invf = exp2f(-(float)fi * (13.287712379549449f / 32.0f));
            const float ang = (float)pos * invf;
            const double rev = (double)ang * 0.15915494309189535; const double fr_ = rev - rint(rev);
            const float f = (float)fr_;
            cosT[i] = __builtin_amdgcn_cosf(f); sinT[i] = __builtin_amdgcn_sinf(f);
        }
        for (int m = gw; m < M; m += NGW) {
            const f32x4* xr = (const f32x4*)(ARGS().in[0] + (size_t)m * 1024) + lane;
            unsigned long long* o8 = (unsigned long long*)(XB + (size_t)m * 1024) + lane; float s = 0.f;
            f32x4 v[4];
#pragma unroll
            for (int j = 0; j < 4; ++j) v[j] = xr[64 * j];
#pragma unroll
            for (int j = 0; j < 4; ++j) { s += (v[j].x * v[j].x + v[j].y * v[j].y) + (v[j].z * v[j].z + v[j].w * v[j].w);
                o8[64 * j] = (unsigned long long)pk2(v[j].x, v[j].y) | ((unsigned long long)pk2(v[j].z, v[j].w) << 32); }
            s = wave_sum(s); if (lane < 4) ssq[(size_t)m * 4 + lane] = lane == 0 ? s : 0.f;
        }
        conv_layer(ARGS(), 0, ws, (LAS float*)(ldsl + wave * 16384), gw, NGW, lane, 0, 3);
    }
    GRID_SYNC();

#pragma nounroll
    for (int step = 0; step < 6; ++step) {
        if (step % 3 != 1) {
            { unsigned char* ws = WSPTR(); const int kind = step % 3;
              pg8::Gemm g{(const bf16*)(ws + WS_XB), (const bf16*)(ws + WS_W + (kind == 0 ? W_GU1 : W_GU2)), M, 5632, 1024, 1024}; pg8::StaticOrder S; S.init(M, 5632, G, bx);
              pg8::EpiFFNUp E{(bf16*)(ws + WS_R1), (const float*)(ws + WS_SSQ) + (size_t)step * M * 4};
              pg8::gemm_phase<pg8::EpiFFNUp, pg8::StaticOrder, true, true>(ldsl, g, S, E); }
            if (step != 5) {
                const int Gv = G, c = bx; const int rounds = (1408 + Gv - 1) / Gv, first_short = 1408 - (rounds - 1) * Gv;
                const bool all = first_short >= Gv;
                if (all || c >= first_short) {
                    unsigned char* ws = WSPTR(); const int tid = opaque_tid(), lane = tid & 63, wave = __builtin_amdgcn_readfirstlane(tid >> 6);
                    const int idx = all ? c : c - first_short, cnt = all ? Gv : Gv - first_short;
                    conv_layer(ARGS(), step == 0 ? 0 : 1, ws, (LAS float*)(ldsl + wave * 16384), idx * NWAVES + wave, cnt * NWAVES, lane, step == 0 ? 3 : (step == 2 ? 0 : 11), step == 0 ? 11 : (step == 2 ? 11 : 14));
                } }
            GRID_SYNC();
            { unsigned char* ws = WSPTR(); const int kind = step % 3;
              pg8::Gemm g{(const bf16*)(ws + WS_R1), (const bf16*)(ws + WS_W + (kind == 0 ? W_D1 : W_D2)), M, 1024, 2816, 2816}; pg8::StaticOrder S; S.init(M, 1024, G, bx);
              pg8::EpiResid E{step == 0 ? ARGS().in[0] : (const float*)ARGS().out, ARGS().out, (bf16*)(ws + WS_XB), (float*)(ws + WS_SSQ) + (size_t)(step + 1) * M * 4, 0.5f};
              pg8::gemm_phase<pg8::EpiResid, pg8::StaticOrder, false, true>(ldsl, g, S, E); }
            if (step != 5) GRID_SYNC();
        } else {
            { unsigned char* ws = WSPTR(); const int l = step / 3;
              pg8::Gemm g{(const bf16*)(ws + WS_XB), (const bf16*)(ws + WS_W + W_QKV), M, 2816, 1024, 1024}; pg8::StaticOrder S; S.init(M, 2816, G, bx);
              pg8::EpiQKV E{(bf16*)(ws + WS_R1), (const float*)(ws + WS_SSQ) + (size_t)step * M * 4, (const float*)(ws + WS_COS), (const float*)(ws + WS_SIN),
                            ARGS().in[7] + l * 64, ARGS().in[8] + l * 64, ARGS().in[9] + l * 64, ARGS().in[10] + l * 64, ARGS().in[12] + l * 64, ARGS().in[13] + l * 64, (float*)(ws + WS_KSUM), attn_body::C2};
              pg8::gemm_phase<pg8::EpiQKV, pg8::StaticOrder, true, true>(ldsl, g, S, E); }
            if (step == 1) {
                const int Gv = G, c = bx; const int rounds = (704 + Gv - 1) / Gv, first_short = 704 - (rounds - 1) * Gv; const bool all = first_short >= Gv;
                if (all || c >= first_short) {
                    unsigned char* ws = WSPTR(); const int tid = opaque_tid(), lane = tid & 63, wave = __builtin_amdgcn_readfirstlane(tid >> 6);
                    const int idx = all ? c : c - first_short, cnt = all ? Gv : Gv - first_short;
                    conv_layer(ARGS(), 0, ws, (LAS float*)(ldsl + wave * 16384), idx * NWAVES + wave, cnt * NWAVES, lane, 11, 14);
                } }
            GRID_SYNC();
            { unsigned char* ws = WSPTR(); const int l = step / 3;
              const attn_body::bf16* QKV = (const attn_body::bf16*)(ws + WS_R1);
              for (int u = bx; u < 256; u += G) { const int h = u >> 6, qb = u & 63;
                  attn_body::moba_gate(qb, QKV + 64 * h, (char*)lds, (const float*)(ws + WS_KSUM) + (size_t)h * 64 * 64, (unsigned*)(ws + WS_CTL) + 3072 + 256 * l + 64 * h, (int*)(ws + WS_MSEL) + (size_t)h * 16384 * 4); } }
            GRID_SYNC();
            { unsigned char* ws = WSPTR(); const int l = step / 3; const int tid = opaque_tid();
              volatile LAS int* T = (volatile LAS int*)(ldsl + MISC_OFF + 1024);
              const unsigned* cnt = (const unsigned*)(ws + WS_CTL) + 3072 + 256 * l;
              if (tid < 256) T[512 + tid] = 256 + (int)__hip_atomic_load(cnt + tid, __ATOMIC_RELAXED, __HIP_MEMORY_SCOPE_AGENT);
              __syncthreads();
              if (tid < 4) { int o = 0, c = 0; for (int b = 0; b < 64; ++b) { const int len = T[512 + tid * 64 + b]; T[tid * 64 + b] = o; T[256 + tid * 64 + b] = c; o += len; c += (len + 255) >> 8; } T[768 + tid] = c; }
              __syncthreads();
              if (tid < 256) { const int h = tid >> 6; const int add = (h > 0 ? T[768] : 0) + (h > 1 ? T[769] : 0) + (h > 2 ? T[770] : 0); T[256 + tid] += add; }
              if (tid == 0) T[772] = T[768] + T[769] + T[770] + T[771];
              __syncthreads();
              int* SEL = (int*)(ws + WS_MSEL); unsigned short* LIST = (unsigned short*)(ws + WS_MLIST);
              for (int e = bx * (NWAVES * 64) + tid; e < 4 * 16384; e += G * NWAVES * 64) { const int h = e >> 14, t = e & 16383;
                  int v0 = SEL[(size_t)e * 4 + 0], v1 = SEL[(size_t)e * 4 + 1], v2 = SEL[(size_t)e * 4 + 2];
                  if (v0 >= 0) { const int r = T[h * 64 + (v0 >> 16)] + 256 + (v0 & 0xffff); LIST[(size_t)h * 65536 + r] = (unsigned short)t; v0 = r; }
                  if (v1 >= 0) { const int r = T[h * 64 + (v1 >> 16)] + 256 + (v1 & 0xffff); LIST[(size_t)h * 65536 + r] = (unsigned short)t; v1 = r; }
                  if (v2 >= 0) { const int r = T[h * 64 + (v2 >> 16)] + 256 + (v2 & 0xffff); LIST[(size_t)h * 65536 + r] = (unsigned short)t; v2 = r; }
                  SEL[(size_t)e * 4 + 0] = v0; SEL[(size_t)e * 4 + 1] = v1; SEL[(size_t)e * 4 + 2] = v2; SEL[(size_t)e * 4 + 3] = T[h * 64 + (t >> 8)] + (t & 255); } }
            GRID_SYNC();
            { unsigned char* ws = WSPTR(); const int l = step / 3; const int tid = opaque_tid();
              volatile LAS unsigned* MISC = (volatile LAS unsigned*)(ldsl + MISC_OFF);
              volatile LAS int* T = (volatile LAS int*)(ldsl + MISC_OFF + 1024);
              unsigned* qctr = (unsigned*)(ws + WS_CTL) + 64 * (1 + l);
              const attn_body::bf16* QKV = (const attn_body::bf16*)(ws + WS_R1); attn_body::bf16* OBa = (attn_body::bf16*)(ws + WS_OB);
              const int TC = T[772];
              for (;;) {
                  if (tid == 0) MISC[0] = atomicAdd(qctr, 1u);
                  __syncthreads(); const int u = __builtin_amdgcn_readfirstlane((int)MISC[0]); __syncthreads();
                  if (u >= 1024 + TC + 256) break;
                  if (u < 1024) { const int qb = 63 - u / 16, hv = u % 16; const int h = hv >> 2, sub = hv & 3;
                      attn_body::attn_unit<0, 8>(qb, 0, QKV + 1280 + 128 * h + 64 * (sub >> 1), QKV + 1792 + 128 * h + 64 * (sub >> 1), QKV + 2304 + 128 * h + 64 * (sub & 1),
                                                 OBa + 512 + 256 * h + 128 * (sub >> 1) + 64 * (sub & 1), (char*)lds, nullptr, 0.f);
                  } else if (u < 1024 + TC) { const int j = u - 1024; int lo = 0, hi = 255;
                      while (lo < hi) { const int mid = (lo + hi + 1) >> 1; if (T[256 + mid] <= j) lo = mid; else hi = mid - 1; }
                      const int i = __builtin_amdgcn_readfirstlane(lo), h = i >> 6, b = i & 63, c = j - T[256 + i], rb = T[i] + 256 * c; const int n = T[512 + i] - 256 * c;
                      attn_body::bf16* PART = (h < 2 ? (attn_body::bf16*)(ws + WS_W + W_GU1) + (size_t)h * 65536 * 64 : (attn_body::bf16*)(ws + WS_OC) + (size_t)(h - 2) * 65536 * 64) + (size_t)rb * 64;
                      attn_body::attn_unit<3, 0>(b, 4 * b, QKV + 64 * h, QKV + 256 + 64 * h, QKV + 512 + 64 * h, PART, (char*)lds, nullptr, 0.f,
                                                 c == 0 ? nullptr : (const unsigned short*)(ws + WS_MLIST) + (size_t)h * 65536 + rb, n < 256 ? n : 256, (float*)(ws + WS_MSTAT) + (size_t)h * 65536 + rb);
                  } else { const int s = u - 1024 - TC, hq = s & 3, qb = s >> 2; const int t0 = qb == 0 ? 0 : 4 * qb - 2;
                      attn_body::attn_unit<2, 8>(qb, t0, QKV + 768 + 64 * hq, QKV + 1024 + 64 * (hq >> 1), QKV + 1152 + 64 * (hq >> 1), OBa + 256 + 64 * hq, (char*)lds, nullptr, ARGS().in[11][l * 4 + hq] * LOG2E); }
              } }
            GRID_SYNC();
            { unsigned char* ws = WSPTR(); const int tid = opaque_tid(), lane = tid & 63, wave = __builtin_amdgcn_readfirstlane(tid >> 6);
              const int gw = bx * NWAVES + wave, NGW = G * NWAVES; const int h = lane >> 4, j4 = (lane & 15) * 4;
              const bf16* PART = h < 2 ? (const bf16*)(ws + WS_W + W_GU1) + (size_t)h * 65536 * 64 : (const bf16*)(ws + WS_OC) + (size_t)(h - 2) * 65536 * 64;
              const float* ST = (const float*)(ws + WS_MSTAT) + (size_t)h * 65536; const int* SEL = (const int*)(ws + WS_MSEL) + (size_t)h * 16384 * 4; bf16* OB = (bf16*)(ws + WS_OB);
              for (int t0 = gw; t0 < 16384; t0 += 4 * NGW) {
                  typedef int i32x4 __attribute__((ext_vector_type(4)));
                  i32x4 rr[4]; float wl[4][4]; unsigned long long qv[4][4];
#pragma unroll
                  for (int k = 0; k < 4; ++k) rr[k] = *(const i32x4*)(SEL + (size_t)(t0 + k * NGW) * 4);
#pragma unroll
                  for (int k = 0; k < 4; ++k)
#pragma unroll
                      for (int q = 0; q < 4; ++q) { const int r = rr[k][q]; const int rc = r >= 0 ? r : 0; const float w = ST[rc]; wl[k][q] = r >= 0 ? w : -INFINITY; qv[k][q] = *(const unsigned long long*)(PART + (size_t)rc * 64 + j4); }
#pragma unroll
                  for (int k = 0; k < 4; ++k) { const int t = t0 + k * NGW;
                      const float mx = fmaxf(fmaxf(wl[k][0], wl[k][1]), fmaxf(wl[k][2], wl[k][3]));
                      float a0 = 0.f, a1 = 0.f, a2 = 0.f, a3 = 0.f, ws_ = 0.f;
#pragma unroll
                      for (int q = 0; q < 4; ++q) { const float w = __builtin_amdgcn_exp2f(wl[k][q] - mx); ws_ += w; const unsigned lo_ = (unsigned)qv[k][q], hi_ = (unsigned)(qv[k][q] >> 32);
                          a0 += w * __uint_as_float(lo_ << 16); a1 += w * __uint_as_float(lo_ & 0xffff0000u); a2 += w * __uint_as_float(hi_ << 16); a3 += w * __uint_as_float(hi_ & 0xffff0000u); }
                      const float inv = 1.0f / ws_;
                      *(unsigned long long*)(OB + (size_t)t * OPW + 64 * h + j4) = (unsigned long long)pk2(a0 * inv, a1 * inv) | ((unsigned long long)pk2(a2 * inv, a3 * inv) << 32); }
              } }
            { unsigned char* ws = WSPTR(); const int l = step / 3;
              const int tid = opaque_tid(), lane = tid & 63, wave = __builtin_amdgcn_readfirstlane(tid >> 6);
              const int gw = bx * NWAVES + wave, NGW = G * NWAVES;
              const bf16* OB = (const bf16*)(ws + WS_OB); bf16* OC = (bf16*)(ws + WS_OCN);
              const float lam_init = l == 0 ? 0.2f : 0.35550907f;
              const float s1 = wave_sum(ARGS().in[14][l * 64 + lane] * ARGS().in[15][l * 64 + lane]), s2 = wave_sum(ARGS().in[16][l * 64 + lane] * ARGS().in[17][l * 64 + lane]);
              const float lam = expf(s1) - expf(s2) + lam_init;
              const int h = lane >> 4, c0 = (lane & 15) * 8;
              f32x4 sg0 = *(const f32x4*)(ARGS().in[18] + l * 128 + c0), sg1 = *(const f32x4*)(ARGS().in[18] + l * 128 + c0 + 4);
              sg0 = sg0 * (1.0f - lam_init); sg1 = sg1 * (1.0f - lam_init);
              for (int m = gw; m < M; m += NGW) {
                  const bf16* op = OB + (size_t)m * OPW + 512 + 256 * h + c0;
                  f32x4 a0, a1, b0, b1; pg8::unpack8(*(const v4u*)op, a0, a1); pg8::unpack8(*(const v4u*)(op + 128), b0, b1);
                  a0 = a0 - b0 * lam; a1 = a1 - b1 * lam;
                  float ss = (a0[0] * a0[0] + a0[1] * a0[1]) + (a0[2] * a0[2] + a0[3] * a0[3]) + (a1[0] * a1[0] + a1[1] * a1[1]) + (a1[2] * a1[2] + a1[3] * a1[3]);
                  ss += __shfl_xor(ss, 1); ss += __shfl_xor(ss, 2); ss += __shfl_xor(ss, 4); ss += __shfl_xor(ss, 8);
                  const float rn = __builtin_amdgcn_rsqf(ss * (1.0f / 128.0f) + 1e-6f);
                  *(v4u*)(OC + (size_t)m * 512 + 128 * h + c0) = pg8::pack8(a0 * rn * sg0, a1 * rn * sg1);
              } }
            GRID_SYNC();
#define BRANCH_PAIR(WG_OFF, A_EXPR, KB, LDA, WB_OFF, FIRST) \
            { unsigned char* ws = WSPTR(); \
              pg8::Gemm g{(const bf16*)(ws + WS_XB), (const bf16*)(ws + WS_W + W_G + (WG_OFF)), M, 1024, 1024, 1024}; pg8::StaticOrder S; S.init(M, 1024, G, bx); \
              pg8::EpiGate E{(bf16*)(ws + WS_R1), (const float*)(ws + WS_SSQ) + (size_t)step * M * 4}; \
              pg8::gemm_phase<pg8::EpiGate, pg8::StaticOrder, true, true>(ldsl, g, S, E); } \
            { unsigned char* ws = WSPTR(); \
              pg8::Gemm g{(const bf16*)(A_EXPR), (const bf16*)(ws + WS_W + (WB_OFF)), M, 1024, (KB), (LDA)}; pg8::StaticOrder S; S.init(M, 1024, G, bx); \
              pg8::EpiBranch E{(const bf16*)(ws + WS_R1), (bf16*)(ws + WS_R1 + 32 * MiB), (FIRST)}; \
              pg8::gemm_phase<pg8::EpiBranch, pg8::StaticOrder, true, true>(ldsl, g, S, E); }
            BRANCH_PAIR((size_t)0, ws + WS_OB, 256, OPW, W_BA, 1)
            BRANCH_PAIR((size_t)1024 * 1024 * 2, ws + WS_OB + 512, 256, OPW, W_BB, 0)
            BRANCH_PAIR((size_t)2 * 1024 * 1024 * 2, ws + WS_OCN, 512, 512, W_BC, 0)
#undef BRANCH_PAIR
            GRID_SYNC();
            { unsigned char* ws = WSPTR();
              pg8::Gemm g{(const bf16*)(ws + WS_R1 + 32 * MiB), (const bf16*)(ws + WS_W + W_O), M, 1024, 1024, 1024}; pg8::StaticOrder S; S.init(M, 1024, G, bx);
              pg8::EpiResid E{(const float*)ARGS().out, ARGS().out, (bf16*)(ws + WS_XB), (float*)(ws + WS_SSQ) + (size_t)(step + 1) * M * 4, 1.0f};
              pg8::gemm_phase<pg8::EpiResid, pg8::StaticOrder, false, true>(ldsl, g, S, E); }
            GRID_SYNC();
        }
    }
}

#undef G
#undef bx
extern "C" void kernel_launch(void* const* d_in, const int* in_sizes, int n_in, void* d_out, int out_size, void* d_ws, size_t ws_size, hipStream_t stream) {
    static int grid = 0;
    if (grid == 0) {
        if (n_in != 27 || out_size != M * DMODEL || ws_size < WS_END) { fprintf(stderr, "kernel_launch: unexpected shapes (n_in %d out %d ws %zu)\n", n_in, out_size, ws_size); grid = -1; return; }
        int dev = 0, cus = 0, per_cu = 0;
        hipGetDevice(&dev); hipDeviceGetAttribute(&cus, hipDeviceAttributeMultiprocessorCount, dev);
        hipFuncSetAttribute((const void*)mega_fwd, hipFuncAttributeMaxDynamicSharedMemorySize, LDS_BYTES);
        hipOccupancyMaxActiveBlocksPerMultiprocessor(&per_cu, (const void*)mega_fwd, NWAVES * 64, LDS_BYTES);
        if (per_cu < 1) { fprintf(stderr, "kernel_launch: occupancy query says %d blocks per CU\n", per_cu); per_cu = 1; }
        (void)hipGetLastError();
        grid = cus;
    }
    if (grid < 0) return;
    (void)hipMemsetAsync((char*)d_ws + WS_BAR, 0, 16384, stream);
    Args a{};
    for (int i = 0; i < 27; ++i) a.in[i] = (const float*)d_in[i];
    a.out = (float*)d_out; a.ws = (unsigned char*)d_ws;
    void* kargs[] = {&a};
    hipError_t e = hipLaunchCooperativeKernel((const void*)mega_fwd, dim3(grid), dim3(NWAVES * 64), kargs, LDS_BYTES, stream);
    if (e != hipSuccess) fprintf(stderr, "cooperative launch failed: %s (grid %d)\n", hipGetErrorString(e), grid);
}
```

```cpp
#include <hip/hip_runtime.h>
#include <cstdio>
#include <cstdint>
#include <hip/hip_cooperative_groups.h>
namespace pg8 {
#define PG8_LAS __attribute__((address_space(3)))
typedef unsigned short bf16_t;
typedef short bf16x8 __attribute__((ext_vector_type(8)));
typedef float f32x4 __attribute__((ext_vector_type(4)));
typedef unsigned u32x4 __attribute__((ext_vector_type(4)));
constexpr int BM = 256, BK = 64, HALF = 128, HTB = HALF * BK * 2  , STAGE_BYTES = 8 * HTB, NXCD = 8, WGM = 8;

__host__ __device__ __forceinline__ int lds_byte(int r, int c) { const int st = (r >> 4) * 2 + (c >> 5), rr = r & 15, cc = c & 31, ob = rr * 64 + cc * 2; return st * 1024 + (ob ^ (((ob >> 9) & 1) << 5)); }
__host__ __device__ __forceinline__ void stage_rc(int b, int& R, int& C) { const int st = b / 1024, sb = b % 1024, swz = sb ^ (((sb >> 9) & 1) << 5); R = (st >> 1) * 16 + swz / 64; C = (st & 1) * 32 + (swz % 64) / 2; }
__host__ __device__ __forceinline__ int perm32(int rho) { const int n = rho >> 4, i = rho & 15; return 8 * (i >> 2) + 4 * n + (i & 3); }

struct Unit { int pm, pn; };
struct Gemm { const bf16_t* A; const bf16_t* Bt; int M, N, K, lda; };

struct StaticOrder {
    int nM, nN, nwg, G, c;
    __host__ __device__ void init(int M, int N, int G_, int c_) { nM = M / BM; nN = N / BM; nwg = nM * nN; G = G_; c = c_; }
    __host__ __device__ bool next(int i, Unit& u) const {
        const long L = (long)i * G + c; if (L >= nwg) return false;
        int wgid = (int)L; { const int q = nwg / NXCD, r = nwg % NXCD, xcd = wgid % NXCD, off = wgid / NXCD; wgid = (xcd < r ? xcd * (q + 1) : r * (q + 1) + (xcd - r) * q) + off; }
        const int nig = WGM * nN, gid = wgid / nig, fm = gid * WGM, gsz = (nM - fm) < WGM ? (nM - fm) : WGM;
        u.pm = fm + ((wgid % nig) % gsz); u.pn = (wgid % nig) / gsz; return true;
    }
    __device__ __forceinline__ void a_ready(const Unit&) const {}
    __device__ __forceinline__ void done(const Unit&) const {}
};

typedef float f32x2_t __attribute__((ext_vector_type(2))); typedef __bf16 bf16x2_t __attribute__((ext_vector_type(2)));
__device__ __forceinline__ unsigned cvt_pk_bf16(float lo, float hi) { f32x2_t v = {lo, hi}; bf16x2_t b = __builtin_convertvector(v, bf16x2_t); return __builtin_bit_cast(unsigned, b); }
__device__ __forceinline__ u32x4 pack8(const f32x4 a, const f32x4 b) { u32x4 w; w.x = cvt_pk_bf16(a[0], a[1]); w.y = cvt_pk_bf16(a[2], a[3]); w.z = cvt_pk_bf16(b[0], b[1]); w.w = cvt_pk_bf16(b[2], b[3]); return w; }
__device__ __forceinline__ void unpack8(const u32x4 w, f32x4& a, f32x4& b) {
    a[0] = __uint_as_float(w.x << 16); a[1] = __uint_as_float(w.x & 0xffff0000u); a[2] = __uint_as_float(w.y << 16); a[3] = __uint_as_float(w.y & 0xffff0000u);
    b[0] = __uint_as_float(w.z << 16); b[1] = __uint_as_float(w.z & 0xffff0000u); b[2] = __uint_as_float(w.w << 16); b[3] = __uint_as_float(w.w & 0xffff0000u); }
__device__ __forceinline__ float rstd_of(const float* ssq, int row) { const f32x4 a = *(const f32x4*)(ssq + (size_t)row * 4);
    return __builtin_amdgcn_rsqf(((a[0] + a[1]) + (a[2] + a[3])) * (1.0f / 1024.0f) + 1e-6f); }
__device__ __forceinline__ float sigm(float g) { return __builtin_amdgcn_rcpf(1.0f + __builtin_amdgcn_exp2f(-1.4426950408889634f * g)); }

struct EpiFFNUp {
    static constexpr bool PERM = false, AFTER_DRAIN = false;
    bf16_t* O; const float* ssq;
    __device__ __forceinline__ void operator()(const f32x4 (&acc)[2][2][4][2], const Unit& u, int wr, int wc, int fr, int fq) const {
        const int row0 = u.pm * BM + wr * 64 + fr, col0 = u.pn * 128 + wc * 32 + 8 * fq;
#pragma unroll
        for (int ai = 0; ai < 2; ++ai)
#pragma unroll
            for (int m = 0; m < 4; ++m) { if (m == 0) asm volatile("" ::: "memory"); const int row = row0 + ai * HALF + m * 16; const float rs = rstd_of(ssq, row);
                f32x4 o[2];
#pragma unroll
                for (int n = 0; n < 2; ++n) { const f32x4 g = acc[ai][0][m][n] * rs, up = acc[ai][1][m][n] * rs;
#pragma unroll
                    for (int e = 0; e < 4; ++e) o[n][e] = g[e] * sigm(g[e]) * up[e]; }
                *(u32x4*)(O + (size_t)row * 2816 + col0) = pack8(o[0], o[1]); }
    }
};
struct EpiResid {
    static constexpr bool PERM = false, AFTER_DRAIN = true;
    const float* Xin; float* X; bf16_t* XB; float* ssq_out; float scale; int last;
    __device__ __forceinline__ void fused(const f32x4 (&acc)[2][2][4][2], const Unit& u, int wr, int wc, int fr, int fq, PG8_LAS unsigned char* lds, int wid, int lane) const {
        PG8_LAS float* P = (PG8_LAS float*)lds;
        const int row0 = u.pm * BM + wr * 64 + fr, col0 = u.pn * BM + wc * 32 + 8 * fq;
#pragma unroll
        for (int ai = 0; ai < 2; ++ai)
#pragma unroll
            for (int m = 0; m < 4; ++m) { if ((m & 1) == 0) asm volatile("" ::: "memory"); const int row = row0 + ai * HALF + m * 16; float ss = 0.f;
#pragma unroll
                for (int bj = 0; bj < 2; ++bj) { float* p = X + (size_t)row * 1024 + col0 + bj * HALF; const float* pi = Xin + (size_t)row * 1024 + col0 + bj * HALF;
                    f32x4 x0 = *(const f32x4*)pi, x1 = *(const f32x4*)(pi + 4);
                    x0 = x0 + acc[ai][bj][m][0] * scale; x1 = x1 + acc[ai][bj][m][1] * scale;
                    *(f32x4*)p = x0; *(f32x4*)(p + 4) = x1;
                    ss += (x0[0] * x0[0] + x0[1] * x0[1]) + (x0[2] * x0[2] + x0[3] * x0[3]) + (x1[0] * x1[0] + x1[1] * x1[1]) + (x1[2] * x1[2] + x1[3] * x1[3]);
                    if (!last) *(u32x4*)(XB + (size_t)row * 1024 + col0 + bj * HALF) = pack8(x0, x1); }
                ss += __shfl_xor(ss, 16); ss += __shfl_xor(ss, 32);
                if (fq == 0 && !last) P[(ai * HALF + wr * 64 + m * 16 + fr) * 4 + wc] = ss; }
        if (last) return;
        asm volatile("s_waitcnt lgkmcnt(0)" ::: "memory"); __builtin_amdgcn_s_barrier(); asm volatile("" ::: "memory");
        { const int r = wid * 32 + (lane & 31);
          if (lane < 32) { const f32x4 q = *(const PG8_LAS f32x4*)(P + r * 4); ssq_out[(size_t)(u.pm * BM + r) * 4 + u.pn] = (q[0] + q[1]) + (q[2] + q[3]); } }
        asm volatile("s_waitcnt lgkmcnt(0)" ::: "memory"); __builtin_amdgcn_s_barrier(); asm volatile("" ::: "memory");
    }
};
struct EpiGate {
    static constexpr bool PERM = false, AFTER_DRAIN = false;
    bf16_t* O; const float* ssq;
    __device__ __forceinline__ void operator()(const f32x4 (&acc)[2][2][4][2], const Unit& u, int wr, int wc, int fr, int fq) const {
        const int row0 = u.pm * BM + wr * 64 + fr, col0 = u.pn * BM + wc * 32 + 8 * fq;
#pragma unroll
        for (int ai = 0; ai < 2; ++ai)
#pragma unroll
            for (int m = 0; m < 4; ++m) { if (m == 0) asm volatile("" ::: "memory"); const int row = row0 + ai * HALF + m * 16; const float rs = rstd_of(ssq, row);
#pragma unroll
                for (int bj = 0; bj < 2; ++bj) { f32x4 o[2];
#pragma unroll
                    for (int n = 0; n < 2; ++n)
#pragma unroll
                        for (int e = 0; e < 4; ++e) o[n][e] = sigm(acc[ai][bj][m][n][e] * rs);
                    *(u32x4*)(O + (size_t)row * 1024 + col0 + bj * HALF) = pack8(o[0], o[1]); } }
    }
    __device__ __forceinline__ void fused(const f32x4 (&acc)[2][2][4][2], const Unit& u, int wr, int wc, int fr, int fq, PG8_LAS unsigned char*, int, int) const { (*this)(acc, u, wr, wc, fr, fq); }
};
struct EpiBranch {
    static constexpr bool PERM = false, AFTER_DRAIN = false;
    const bf16_t* G; bf16_t* Mg; int first;
    __device__ __forceinline__ void operator()(const f32x4 (&acc)[2][2][4][2], const Unit& u, int wr, int wc, int fr, int fq) const {
        const int row0 = u.pm * BM + wr * 64 + fr, col0 = u.pn * BM + wc * 32 + 8 * fq;
#pragma unroll
        for (int ai = 0; ai < 2; ++ai)
#pragma unroll
            for (int m = 0; m < 4; ++m) { if ((m & 1) == 0) asm volatile("" ::: "memory"); const int row = row0 + ai * HALF + m * 16;
#pragma unroll
                for (int bj = 0; bj < 2; ++bj) { const size_t off = (size_t)row * 1024 + col0 + bj * HALF;
                    f32x4 g0, g1; unpack8(*(const u32x4*)(G + off), g0, g1);
                    f32x4 o0 = acc[ai][bj][m][0] * g0, o1 = acc[ai][bj][m][1] * g1;
                    if (!first) { f32x4 p0, p1; unpack8(*(const u32x4*)(Mg + off), p0, p1); o0 = o0 + p0; o1 = o1 + p1; }
                    *(u32x4*)(Mg + off) = pack8(o0, o1); } }
    }
    __device__ __forceinline__ void fused(const f32x4 (&acc)[2][2][4][2], const Unit& u, int wr, int wc, int fr, int fq, PG8_LAS unsigned char*, int, int) const { (*this)(acc, u, wr, wc, fr, fq); }
};
struct EpiQKV {
    static constexpr bool PERM = false, AFTER_DRAIN = false;
    bf16_t* O; const float* ssq; const float* cosT; const float* sinT;
    const float *gqa, *gka, *gqb, *gkb, *gqc, *gkc; float* ksum; float c2;
    __device__ __forceinline__ void operator()(const f32x4 (&acc)[2][2][4][2], const Unit& u, int wr, int wc, int fr, int fq) const {
        const int g = 4 * u.pn + wc; const int row0 = u.pm * BM + wr * 64 + fr;
        int kind = 0; const float* gp = gqa; float osc = 1.f; bool dok = false;
        if (g < 4) { kind = 1; gp = gqa; osc = c2; } else if (g < 8) { kind = 1; gp = gka; dok = true; } else if (g < 12) { kind = 0; }
        else if (g < 16) { kind = 1; gp = gqb; osc = c2; } else if (g < 18) { kind = 1; gp = gkb; } else if (g < 20) { kind = 0; }
        else if (g < 28) { kind = 1; gp = gqc; osc = c2; } else if (g < 36) { kind = 1; gp = gkc; } else { kind = 0; }
        bf16_t* ob = O + 64 * g + 8 * fq;
        if (kind == 0) {
#pragma unroll
            for (int ai = 0; ai < 2; ++ai)
#pragma unroll
                for (int m = 0; m < 4; ++m) { if (m == 0) asm volatile("" ::: "memory"); const int row = row0 + ai * HALF + m * 16; const float rs = rstd_of(ssq, row);
#pragma unroll
                    for (int bj = 0; bj < 2; ++bj) *(u32x4*)(ob + (size_t)row * 2816 + 32 * bj) = pack8(acc[ai][bj][m][0] * rs, acc[ai][bj][m][1] * rs); }
        } else {
            f32x4 gv[2][2], cs[2][2];
#pragma unroll
            for (int bj = 0; bj < 2; ++bj)
#pragma unroll
                for (int n = 0; n < 2; ++n) { gv[bj][n] = *(const f32x4*)(gp + 32 * bj + 8 * fq + 4 * n); cs[bj][n] = (f32x4){0.f, 0.f, 0.f, 0.f}; }
#pragma unroll
            for (int ai = 0; ai < 2; ++ai)
#pragma unroll
                for (int m = 0; m < 4; ++m) { if (m == 0) asm volatile("" ::: "memory"); const int row = row0 + ai * HALF + m * 16; const float rs = rstd_of(ssq, row);
                    f32x4 v[2][2]; float ss = 0.f;
#pragma unroll
                    for (int bj = 0; bj < 2; ++bj)
#pragma unroll
                        for (int n = 0; n < 2; ++n) { v[bj][n] = acc[ai][bj][m][n] * rs; const f32x4 q = v[bj][n] * v[bj][n]; ss += (q[0] + q[1]) + (q[2] + q[3]); }
                    ss += __shfl_xor(ss, 16); ss += __shfl_xor(ss, 32);
                    const float rn = __builtin_amdgcn_rsqf(ss * (1.0f / 64.0f) + 1e-6f);
                    f32x4 o[2][2];
#pragma unroll
                    for (int n = 0; n < 2; ++n) { const f32x4 c = *(const f32x4*)(cosT + (size_t)row * 32 + 8 * fq + 4 * n), s = *(const f32x4*)(sinT + (size_t)row * 32 + 8 * fq + 4 * n);
                        const f32x4 y1 = v[0][n] * rn * gv[0][n], y2 = v[1][n] * rn * gv[1][n];
                        o[0][n] = y1 * c - y2 * s; o[1][n] = y2 * c + y1 * s; }
                    if (dok) {
#pragma unroll
                        for (int bj = 0; bj < 2; ++bj)
#pragma unroll
                            for (int n = 0; n < 2; ++n) cs[bj][n] = cs[bj][n] + o[bj][n]; }
#pragma unroll
                    for (int bj = 0; bj < 2; ++bj) *(u32x4*)(ob + (size_t)row * 2816 + 32 * bj) = pack8(o[bj][0] * osc, o[bj][1] * osc); }
            if (dok) {
#pragma unroll
                for (int bj = 0; bj < 2; ++bj)
#pragma unroll
                    for (int n = 0; n < 2; ++n)
#pragma unroll
                        for (int e = 0; e < 4; ++e) { float t = cs[bj][n][e]; t += __shfl_xor(t, 1); t += __shfl_xor(t, 2); t += __shfl_xor(t, 4); t += __shfl_xor(t, 8); cs[bj][n][e] = t; }
                if (fr == 0) { float* kp = ksum + ((size_t)((wr * 4 + (g - 4)) * 64 + u.pm)) * 64 + 8 * fq;
#pragma unroll
                    for (int bj = 0; bj < 2; ++bj)
#pragma unroll
                        for (int n = 0; n < 2; ++n) *(f32x4*)(kp + 32 * bj + 4 * n) = cs[bj][n]; }
            }
        }
    }
};

template <class Epi, class Sched, bool ALIGN_EPI = false, bool SP2 = false>
__device__ __forceinline__ void gemm_phase(PG8_LAS unsigned char* lds, const Gemm g, const Sched& S, const Epi& E) {
    int tid_ = threadIdx.x; asm volatile("" : "+v"(tid_)); const int tid = tid_, wid = __builtin_amdgcn_readfirstlane(tid >> 6), lane = tid & 63, wr = wid >> 2, wc = wid & 3, fr = lane & 15, fq = lane >> 4;
    const int K = g.K, nt = K / BK;
    unsigned voffA[2], voffB[2];
#pragma unroll
    for (int i = 0; i < 2; ++i) { int R, C; stage_rc(tid * 16 + i * 8192, R, C); const int Rb = Epi::PERM ? ((R & ~31) + perm32(R & 31)) : R;
        voffA[i] = (unsigned)(R * g.lda + C) * 2u; voffB[i] = (unsigned)(Rb * K + C) * 2u; }
    const size_t kstep = (size_t)(BK * 2);
    const size_t hstepB = (size_t)HALF * K * 2, hstepA = (size_t)HALF * g.lda * 2;
    const size_t tstepB = 2 * hstepB, tstepA = 2 * hstepA;
    const unsigned ldsw = (unsigned)wid * 1024u;
    const int aoff = lds_byte(wr * 64 + fr, fq * 8), boff = lds_byte(wc * 32 + fr, fq * 8);
#define PG8_SA(b, h) (((b) * 2 + (h)) * HTB)
#define PG8_SB(b, h) ((4 + (b) * 2 + (h)) * HTB)
#define PG8_STAGE(bufoff, gbase, voff) do { _Pragma("unroll") for (int _i = 0; _i < 2; ++_i) \
        __builtin_amdgcn_global_load_lds((const unsigned*)((const char*)(gbase) + (voff)[_i]), (PG8_LAS unsigned*)(lds + (bufoff) + ldsw + _i * 8192), 16, 0, 0); } while (0)
#define PG8_LDA(dst, b, h) do { _Pragma("unroll") for (int m = 0; m < 4; ++m) _Pragma("unroll") for (int k = 0; k < 2; ++k) dst[m][k] = *(const PG8_LAS bf16x8*)(lds + PG8_SA(b, h) + aoff + m * 2048 + k * 1024); } while (0)
#define PG8_LDB(dst, b, h) do { _Pragma("unroll") for (int n = 0; n < 2; ++n) _Pragma("unroll") for (int k = 0; k < 2; ++k) dst[n][k] = *(const PG8_LAS bf16x8*)(lds + PG8_SB(b, h) + boff + n * 2048 + k * 1024); } while (0)
#define PG8_MMA(ai, bj, At, Bt) do { __builtin_amdgcn_s_setprio(1); _Pragma("unroll") for (int m = 0; m < 4; ++m) _Pragma("unroll") for (int n = 0; n < 2; ++n) _Pragma("unroll") for (int k = 0; k < 2; ++k) \
        acc[ai][bj][m][n] = __builtin_amdgcn_mfma_f32_16x16x32_bf16(Bt[n][k], At[m][k], acc[ai][bj][m][n], 0, 0, 0); __builtin_amdgcn_s_setprio(0); } while (0)
#define PG8_WAIT_V(n) asm volatile("s_waitcnt vmcnt(" #n ")" ::: "memory")
#define PG8_WAIT_L(n) asm volatile("s_waitcnt lgkmcnt(" #n ")" ::: "memory")
#define PG8_BAR __builtin_amdgcn_s_barrier()
#define PG8_SCHED __builtin_amdgcn_sched_barrier(0)
    Unit cur, nxt; int ui = 0;
    if (!S.next(0, cur)) return;
    f32x4 acc[2][2][4][2];
#pragma unroll
    for (int a = 0; a < 2; ++a)
#pragma unroll
        for (int b = 0; b < 2; ++b)
#pragma unroll
            for (int m = 0; m < 4; ++m)
#pragma unroll
                for (int n = 0; n < 2; ++n) acc[a][b][m][n] = (f32x4){0.f, 0.f, 0.f, 0.f};
    bf16x8 At[4][2], B0[2][2], B1[2][2];
    const char* cA = (const char*)g.A + (size_t)cur.pm * tstepA; const char* cB = (const char*)g.Bt + (size_t)cur.pn * tstepB;
    S.a_ready(cur);
    if constexpr (SP2) {
        PG8_STAGE(PG8_SB(0, 0), cB, voffB); PG8_STAGE(PG8_SB(0, 1), cB + hstepB, voffB); PG8_STAGE(PG8_SA(0, 0), cA, voffA); PG8_STAGE(PG8_SA(0, 1), cA + hstepA, voffA);
        if (wr == 1) PG8_BAR;
        PG8_WAIT_V(2); PG8_BAR;
        PG8_STAGE(PG8_SB(1, 0), cB + kstep, voffB); PG8_STAGE(PG8_SA(1, 0), cA + kstep, voffA); PG8_STAGE(PG8_SB(1, 1), cB + hstepB + kstep, voffB);
        PG8_WAIT_V(6); PG8_BAR;
    } else {
        PG8_STAGE(PG8_SB(0, 0), cB, voffB); PG8_STAGE(PG8_SA(0, 0), cA, voffA); PG8_STAGE(PG8_SB(0, 1), cB + hstepB, voffB); PG8_STAGE(PG8_SA(0, 1), cA + hstepA, voffA);
        if (wr == 1) PG8_BAR;
        PG8_WAIT_V(4); PG8_BAR;
        PG8_STAGE(PG8_SB(1, 0), cB + kstep, voffB); PG8_STAGE(PG8_SA(1, 0), cA + kstep, voffA); PG8_STAGE(PG8_SB(1, 1), cB + hstepB + kstep, voffB);
        PG8_WAIT_V(6); PG8_BAR;
    }
    for (;;) {
        const bool has_next = S.next(ui + 1, nxt);
        const char* nA = has_next ? (const char*)g.A + (size_t)nxt.pm * tstepA : cA; const char* nB = has_next ? (const char*)g.Bt + (size_t)nxt.pn * tstepB : cB;
        for (int t = 0; t < nt; t += 2) {
            const bool last = (t == nt - 2);
            const char* a1 = cA + (size_t)(t + 1) * kstep;
            const char* a2 = last ? nA : cA + (size_t)(t + 2) * kstep; const char* b2 = last ? nB : cB + (size_t)(t + 2) * kstep;
            const char* a3 = a2 + kstep; const char* b3 = b2 + kstep;
            if (last && has_next) S.a_ready(nxt);
            if constexpr (SP2) {
            PG8_LDB(B0, 0, 0); PG8_LDB(B1, 0, 1); PG8_SCHED; PG8_LDA(At, 0, 0); PG8_STAGE(PG8_SA(1, 1), a1 + hstepA, voffA);
            PG8_WAIT_V(8); PG8_WAIT_L(0); PG8_BAR; PG8_MMA(0, 0, At, B0); PG8_MMA(0, 1, At, B1); PG8_BAR; PG8_SCHED;
            PG8_LDA(At, 0, 1); PG8_STAGE(PG8_SB(0, 0), b2, voffB); PG8_STAGE(PG8_SB(0, 1), b2 + hstepB, voffB); PG8_STAGE(PG8_SA(0, 0), a2, voffA);
            PG8_WAIT_V(8); PG8_WAIT_L(0); PG8_BAR; PG8_MMA(1, 0, At, B0); PG8_MMA(1, 1, At, B1); PG8_BAR; PG8_SCHED;
            PG8_LDB(B0, 1, 0); PG8_LDB(B1, 1, 1); PG8_SCHED; PG8_LDA(At, 1, 0); PG8_STAGE(PG8_SA(0, 1), a2 + hstepA, voffA);
            PG8_WAIT_V(8); PG8_WAIT_L(0); PG8_BAR; PG8_MMA(0, 0, At, B0); PG8_MMA(0, 1, At, B1); PG8_BAR; PG8_SCHED;
            PG8_LDA(At, 1, 1); PG8_STAGE(PG8_SB(1, 0), b3, voffB); PG8_STAGE(PG8_SB(1, 1), b3 + hstepB, voffB); PG8_STAGE(PG8_SA(1, 0), a3, voffA);
            PG8_WAIT_V(8); PG8_WAIT_L(0); PG8_BAR; PG8_MMA(1, 0, At, B0); PG8_MMA(1, 1, At, B1); PG8_BAR; PG8_SCHED;
            } else {
            PG8_LDB(B0, 0, 0); PG8_SCHED; PG8_LDA(At, 0, 0); PG8_STAGE(PG8_SA(1, 1), a1 + hstepA, voffA);
            PG8_WAIT_L(8); PG8_BAR; PG8_WAIT_L(0); PG8_MMA(0, 0, At, B0); PG8_BAR; PG8_SCHED;
            PG8_LDB(B1, 0, 1); PG8_STAGE(PG8_SB(0, 0), b2, voffB);
            PG8_BAR; PG8_WAIT_L(0); PG8_MMA(0, 1, At, B1); PG8_BAR;
            PG8_LDA(At, 0, 1); PG8_STAGE(PG8_SA(0, 0), a2, voffA);
            PG8_BAR; PG8_WAIT_L(0); PG8_MMA(1, 0, At, B0); PG8_BAR; PG8_SCHED;
            PG8_STAGE(PG8_SB(0, 1), b2 + hstepB, voffB);
            PG8_WAIT_V(6); PG8_BAR; PG8_MMA(1, 1, At, B1); PG8_BAR;
            PG8_LDB(B0, 1, 0); PG8_SCHED; PG8_LDA(At, 1, 0); PG8_STAGE(PG8_SA(0, 1), a2 + hstepA, voffA);
            PG8_WAIT_L(8); PG8_BAR; PG8_WAIT_L(0); PG8_MMA(0, 0, At, B0); PG8_BAR; PG8_SCHED;
            PG8_LDB(B1, 1, 1); PG8_STAGE(PG8_SB(1, 0), b3, voffB);
            PG8_BAR; PG8_WAIT_L(0); PG8_MMA(0, 1, At, B1); PG8_BAR;
            PG8_LDA(At, 1, 1); PG8_STAGE(PG8_SA(1, 0), a3, voffA);
            PG8_BAR; PG8_WAIT_L(0); PG8_MMA(1, 0, At, B0); PG8_BAR; PG8_SCHED;
            PG8_STAGE(PG8_SB(1, 1), b3 + hstepB, voffB);
            PG8_WAIT_V(6); PG8_BAR; PG8_MMA(1, 1, At, B1); PG8_BAR;
            }
        }
        if constexpr (ALIGN_EPI) { if (wr == 0) PG8_BAR; }
        if constexpr (!Epi::AFTER_DRAIN) { E(acc, cur, wr, wc, fr, fq); S.done(cur); }
        if (!has_next) break;
#pragma unroll
        for (int a = 0; a < 2; ++a)
#pragma unroll
            for (int b = 0; b < 2; ++b)
#pragma unroll
                for (int m = 0; m < 4; ++m)
#pragma unroll
                    for (int n = 0; n < 2; ++n) acc[a][b][m][n] = (f32x4){0.f, 0.f, 0.f, 0.f};
        cur = nxt; cA = nA; cB = nB; ++ui;
        if constexpr (ALIGN_EPI) { if (wr == 1) PG8_BAR; }
    }
    PG8_WAIT_V(0);
    if constexpr (!ALIGN_EPI) { if (wr == 0) PG8_BAR; }
    PG8_BAR;
    if constexpr (Epi::AFTER_DRAIN) { E.fused(acc, cur, wr, wc, fr, fq, lds, wid, lane); S.done(cur); }
#undef PG8_SA
#undef PG8_SB
#undef PG8_STAGE
#undef PG8_LDA
#undef PG8_LDB
#undef PG8_MMA
#undef PG8_WAIT_V
#undef PG8_WAIT_L
#undef PG8_BAR
#undef PG8_SCHED
}
}

#ifndef PG8_SP2
#define PG8_SP2 true
#endif
#ifndef PG8_ALIGN
#define PG8_ALIGN true
#endif

#include <hip/hip_bf16.h>
#include <cmath>
namespace attn_body {
using bf16=__hip_bfloat16;
using bf16x8=__attribute__((ext_vector_type(8)))short;
using s16x4=__attribute__((ext_vector_type(4)))short;
using f32x16=__attribute__((ext_vector_type(16)))float;
using u32x4=__attribute__((ext_vector_type(4)))unsigned;
constexpr int D=64,DM=2816,OPITCH=1536;
constexpr int NW=8,QBLK=32,QB=QBLK*NW,KVBLK=64;
constexpr int ATTN_PITCH=DM, ATTN_UNIT_ROWS=QB;
__device__ __forceinline__ int crow(int r,int hi){return (r&3)+8*(r>>2)+4*hi;}
#define SBAR() __builtin_amdgcn_sched_barrier(0)
constexpr float NEGV=-1000.0f;
__device__ __forceinline__ void cmask(f32x16&p0,f32x16&p1,int jb,int qrel,int hi){
  const float NEG=NEGV; int kb=64*jb+4*hi;
  #pragma unroll
  for(int r=0;r<16;++r){int kv=kb+(r&3)+8*(r>>2); if(kv>qrel)p0[r]=NEG; if(kv+32>qrel)p1[r]=NEG;}
}
__device__ __forceinline__ void swamask(f32x16&p0,f32x16&p1,int jb,int qrel,int hi){
  const float NEG=NEGV; int kb=64*jb+4*hi;
  #pragma unroll
  for(int r=0;r<16;++r){int kv=kb+(r&3)+8*(r>>2); if(kv>qrel||kv<qrel-127)p0[r]=NEG; if(kv+32>qrel||kv+32<qrel-127)p1[r]=NEG;}
}
__device__ __forceinline__ void mobamask(f32x16&p0,f32x16&p1,unsigned long long sel,int b){
  const float NEG=NEGV; const bool keep=((sel>>b)&1ull)!=0ull;
  #pragma unroll
  for(int r=0;r<16;++r){ p0[r]=keep?p0[r]:NEG; p1[r]=keep?p1[r]:NEG; }
}

constexpr int NSLOT=3, SLOTB=8192;
constexpr int LDS_K=0, LDS_V=NSLOT*SLOTB, LDS_WS=2*NSLOT*SLOTB, LDS_OST=LDS_WS+NW*64*4, LDS_BYTES=LDS_OST+NW*4096;
constexpr float C2=0.125f*1.4426950408889634f;
__device__ __forceinline__ void glds16(const void*gsrc,unsigned lds_dst){unsigned keep;
  asm volatile("s_mov_b32 %0, m0\n\ts_mov_b32 m0, %2\n\ts_nop 0\n\tglobal_load_lds_dwordx4 %1, off\n\ts_mov_b32 m0, %0":"=&s"(keep):"v"(gsrc),"s"(lds_dst):"memory");}
__device__ __forceinline__ float max3f(float a,float b,float c){float r;asm("v_max3_f32 %0, %1, %2, %3":"=v"(r):"v"(a),"v"(b),"v"(c));return r;}
__device__ __forceinline__ float max2f(float a,float b){float r;asm("v_max_f32_e32 %0, %1, %2":"=v"(r):"v"(a),"v"(b));return r;}
__device__ __forceinline__ float fadd_s(float a,float b){float r;asm("v_add_f32_e32 %0, %1, %2":"=v"(r):"v"(a),"v"(b));return r;}
__device__ __forceinline__ float fsub_s(float a,float b){float r;asm("v_sub_f32_e32 %0, %1, %2":"=v"(r):"v"(a),"v"(b));return r;}
typedef float f32x2_t __attribute__((ext_vector_type(2))); typedef __bf16 bf16x2_t __attribute__((ext_vector_type(2)));
__device__ __forceinline__ unsigned cvtpk_s(float lo,float hi){f32x2_t v={lo,hi};bf16x2_t b=__builtin_convertvector(v,bf16x2_t);return __builtin_bit_cast(unsigned,b);}
#define WAIT_BAR(N) asm volatile("s_waitcnt vmcnt(" #N ") lgkmcnt(0)\n\ts_barrier":::"memory")

__device__ __forceinline__ void qkt(f32x16&p0,f32x16&p1,const char*Kslot,const bf16x8*qr,const f32x16&negm,int r32,int hi){
  const char*kb=Kslot+hi*1024+r32*16;
  #pragma unroll
  for(int d0=0;d0<4;++d0){
    const bf16x8 b0=*reinterpret_cast<const bf16x8*>(kb+d0*2048);
    const bf16x8 b1=*reinterpret_cast<const bf16x8*>(kb+d0*2048+512);
    if(d0==0){p0=__builtin_amdgcn_mfma_f32_32x32x16_bf16(b0,qr[0],negm,0,0,0);p1=__builtin_amdgcn_mfma_f32_32x32x16_bf16(b1,qr[0],negm,0,0,0);}
    else{p0=__builtin_amdgcn_mfma_f32_32x32x16_bf16(b0,qr[d0],p0,0,0,0);p1=__builtin_amdgcn_mfma_f32_32x32x16_bf16(b1,qr[d0],p1,0,0,0);}}
}
typedef __attribute__((address_space(3))) const char* lds_cptr;
typedef short v4i16_t __attribute__((ext_vector_type(4)));
__device__ __forceinline__ void kload8(bf16x8*kf,lds_cptr kp){
  kf[0]=*(const __attribute__((address_space(3))) bf16x8*)(kp);      kf[1]=*(const __attribute__((address_space(3))) bf16x8*)(kp+512);
  kf[2]=*(const __attribute__((address_space(3))) bf16x8*)(kp+2048); kf[3]=*(const __attribute__((address_space(3))) bf16x8*)(kp+2560);
  kf[4]=*(const __attribute__((address_space(3))) bf16x8*)(kp+4096); kf[5]=*(const __attribute__((address_space(3))) bf16x8*)(kp+4608);
  kf[6]=*(const __attribute__((address_space(3))) bf16x8*)(kp+6144); kf[7]=*(const __attribute__((address_space(3))) bf16x8*)(kp+6656);
}
__device__ __forceinline__ void kload2(bf16x8*kf,lds_cptr kp,int j){ kf[2*j]=*(const __attribute__((address_space(3))) bf16x8*)(kp+j*2048); kf[2*j+1]=*(const __attribute__((address_space(3))) bf16x8*)(kp+j*2048+512); }
__device__ __forceinline__ s16x4 vtr(lds_cptr p){ return __builtin_bit_cast(s16x4,__builtin_amdgcn_ds_read_tr16_b64_v4i16((__attribute__((address_space(3))) v4i16_t*)p)); }
__device__ __forceinline__ float rowmax(const f32x16&p0,const f32x16&p1){
  float a=max3f(p0[0],p0[1],p1[0]),b=max3f(p0[2],p0[3],p1[1]);a=max3f(a,p1[2],p1[3]);
  #pragma unroll
  for(int r=4;r<16;r+=4){a=max3f(a,p0[r],p0[r+1]);b=max3f(b,p0[r+2],p0[r+3]);a=max3f(a,p1[r],p1[r+1]);b=max3f(b,p1[r+2],p1[r+3]);}
  const float m=max2f(a,b);
  auto rr=__builtin_amdgcn_permlane32_swap(__float_as_uint(m),__float_as_uint(m),false,false);
  return max2f(__uint_as_float(rr[0]),__uint_as_float(rr[1]));
}
__device__ __forceinline__ void pv(f32x16*o,int vb,bf16x8 pa0,bf16x8 pa1,bf16x8 pa2,bf16x8 pa3){
  #pragma unroll
  for(int d0=0;d0<2;++d0){s16x4 lo[4],hi[4];
    #pragma unroll
    for(int ks=0;ks<4;++ks){
      asm volatile("ds_read_b64_tr_b16 %0,%1 offset:%c2":"=&v"(lo[ks]):"v"(vb),"i"(d0*4096+ks*1024):"memory");
      asm volatile("ds_read_b64_tr_b16 %0,%1 offset:%c2":"=&v"(hi[ks]):"v"(vb),"i"(d0*4096+ks*1024+512):"memory");}
    asm volatile("s_waitcnt lgkmcnt(0)":::"memory");SBAR();
    #define PK(k) (bf16x8){lo[k][0],lo[k][1],lo[k][2],lo[k][3],hi[k][0],hi[k][1],hi[k][2],hi[k][3]}
    o[d0]=__builtin_amdgcn_mfma_f32_32x32x16_bf16(pa0,PK(0),o[d0],0,0,0);
    o[d0]=__builtin_amdgcn_mfma_f32_32x32x16_bf16(pa1,PK(1),o[d0],0,0,0);
    o[d0]=__builtin_amdgcn_mfma_f32_32x32x16_bf16(pa2,PK(2),o[d0],0,0,0);
    o[d0]=__builtin_amdgcn_mfma_f32_32x32x16_bf16(pa3,PK(3),o[d0],0,0,0);
    #undef PK
  }
}

#ifndef ATTN_STORE16
#define ATTN_STORE16(p,v) (*(u32x4*)(p)=(v))
#endif
template<int MODE,int THRL> __device__ __forceinline__ void attn_unit(int qb,int t0,const bf16*Q,const bf16*__restrict__ K,const bf16*__restrict__ V,bf16*O,char*shm,const float*ksum,float sinkl2,const unsigned short*list=nullptr,int len=256,float*stat=nullptr){
  int tid_=threadIdx.x; asm volatile("":"+v"(tid_)); const int tid=tid_,lane=tid&63,r32=lane&31,hi=lane>>5; const int wid=__builtin_amdgcn_readfirstlane(tid>>6);
  const int q0=qb*QB;
  const bf16*Qw=Q+(long)(q0+wid*QBLK)*DM;
  const bf16*Kh=K+(long)t0*KVBLK*DM,*Vh=V+(long)t0*KVBLK*DM;
  const unsigned lds0=(unsigned)(uintptr_t)shm;
  float*wsf=(float*)(shm+LDS_WS)+wid*64;
  const bf16*ksrc=Kh+(long)lane*DM+wid*8;
  const bf16*vsrc=Vh+(long)(16*(wid&3)+(lane>>2))*DM+(wid>>2)*32+(lane&3)*8;
  const unsigned kdst=lds0+LDS_K+wid*1024, vdst=lds0+LDS_V+wid*1024;
  #define DMA_K(t,slot) glds16(ksrc+(long)(t)*KVBLK*DM,(unsigned)__builtin_amdgcn_readfirstlane(kdst+(slot)))
  #define DMA_V(t,slot) glds16(vsrc+(long)(t)*KVBLK*DM,(unsigned)__builtin_amdgcn_readfirstlane(vdst+(slot)))
  const int vb0=(int)(lds0+LDS_V)+((lane>>4)&1)*32+(lane&3)*8+(4*hi+((lane&15)>>2))*64;
  const char*Kbase=shm+LDS_K; bf16x8 kf[8];
  const lds_cptr shm3=(lds_cptr)shm; const lds_cptr kp0=shm3+LDS_K+hi*1024+r32*16; const lds_cptr vp0=shm3+LDS_V+((lane>>4)&1)*32+(lane&3)*8+(4*hi+((lane&15)>>2))*64;
  const int NT=(q0+QB)/KVBLK-t0;
  bf16x8 qr[4]; unsigned long long sel=0ull;
  const bf16*Qrow=Qw+(long)r32*DM;
  if(MODE==3){ const int p_=wid*QBLK+r32; const long trow_=list?(long)list[p_<len?p_:len-1]:(long)(q0+p_); Qrow=Q+trow_*DM; }
  if(MODE==1){
    #pragma unroll
    for(int d0=0;d0<4;++d0)qr[d0]=*reinterpret_cast<const bf16x8*>(&Qrow[d0*16+hi*8]);
    float*km=(float*)(shm+86016);
    #pragma unroll
    for(int i=0;i<8;++i){const int e=tid+512*i; km[e]=(ksum[e]+ksum[e+4*64*64])*(1.0f/256.0f);}
    asm volatile("s_waitcnt vmcnt(0) lgkmcnt(0)\n\ts_barrier":::"memory");
    float qf[32];
    #pragma unroll
    for(int d0=0;d0<4;++d0)
      #pragma unroll
      for(int j=0;j<8;++j)qf[d0*8+j]=__uint_as_float(((unsigned)(unsigned short)qr[d0][j])<<16);
    float t1=-INFINITY,t2=-INFINITY,t3=-INFINITY; int i1=-1,i2=-1,i3=-1;
    for(int b=0;b<qb;++b){
      const float*kr=km+b*64+hi*8; float g=0.f;
      #pragma unroll
      for(int d0=0;d0<4;++d0)
        #pragma unroll
        for(int j=0;j<8;++j)g+=qf[d0*8+j]*kr[d0*16+j];
      g+=__shfl_xor(g,32);
      if(g>t3){ if(g>t2){ t3=t2;i3=i2; if(g>t1){t2=t1;i2=i1;t1=g;i1=b;} else {t2=g;i2=b;} } else {t3=g;i3=b;} }
    }
    if(i1>=0)sel|=1ull<<i1; if(i2>=0)sel|=1ull<<i2; if(i3>=0)sel|=1ull<<i3;
  }
  DMA_K(0,0);DMA_V(0,0);DMA_K(1,SLOTB);
  if(MODE!=1){
    #pragma unroll
    for(int d0=0;d0<4;++d0)qr[d0]=*reinterpret_cast<const bf16x8*>(&Qrow[d0*16+hi*8]);
  }
  float mhat=0.f,l_reg=0.f;f32x16 o[2];o[0]=f32x16{};o[1]=f32x16{};f32x16 negm=f32x16{};asm volatile("":"+v"(negm));
  const int qrel=wid*QBLK+r32;
  #define CMASK(P0,P1,t) do{int jb_=(t)-(NT-4); if(MODE==3){ if(!list&&jb_>=0)cmask(P0,P1,jb_,qrel,hi); } else if(MODE==2){swamask(P0,P1,jb_,qrel,hi);} else if(jb_>=0){cmask(P0,P1,jb_,qrel,hi);} else if(MODE==1){mobamask(P0,P1,sel,(t)>>2);} }while(0)
  bool resc=false;
  #define START(P0,P1) do{ const float rm=rowmax(P0,P1); resc=false; \
    { const float dl=rm; mhat=fadd_s(mhat,dl); \
      _Pragma("unroll") for(int r=0;r<16;++r){P0[r]=fsub_s(P0[r],dl);P1[r]=fsub_s(P1[r],dl);} \
      _Pragma("unroll") for(int r=0;r<16;++r)negm[r]=-mhat; asm volatile("":"+v"(negm)); } \
    _Pragma("unroll") for(int r=0;r<16;++r)P0[r]=__builtin_amdgcn_exp2f(P0[r]); }while(0)
  #define RESC() do{ if(resc){ asm volatile("s_waitcnt lgkmcnt(0)":::"memory"); \
      _Pragma("unroll") for(int d_=0;d_<2;++d_) _Pragma("unroll") for(int r=0;r<16;++r)o[d_][r]*=wsf[crow(r,hi)]; } }while(0)
  f32x16 pA0,pA1,pB0,pB1;
  int sl_prev=0,sl_cur=0,sl_next=SLOTB;
  #define ROT() do{sl_prev=sl_cur;sl_cur=sl_next;sl_next=(sl_next==(NSLOT-1)*SLOTB)?0:sl_next+SLOTB;}while(0)
  DMA_K(2,2*SLOTB);
  WAIT_BAR(3);
  qkt(pA0,pA1,Kbase,qr,negm,r32,hi);asm volatile("s_nop 15\n\ts_nop 7":"+v"(pA0),"+v"(pA1));CMASK(pA0,pA1,0);
  START(pA0,pA1);
  _Pragma("unroll") for(int r=0;r<16;++r)pA1[r]=__builtin_amdgcn_exp2f(pA1[r]);
  WAIT_BAR(0);
  DMA_K(3,0);DMA_V(1,SLOTB);
  ROT();
  kload8(kf,kp0+sl_cur);
  WAIT_BAR(2);
  s16x4 vlo[8],vhi[8]; u32x4 pw0,pw1,pw2,pw3;
  #define PKW(P,B) cvtpk_s(P[B],P[B+1])
  #define PAF(k) __builtin_bit_cast(bf16x8,pw##k)
  #define VFR(i) (bf16x8){vlo[i][0],vlo[i][1],vlo[i][2],vlo[i][3],vhi[i][0],vhi[i][1],vhi[i][2],vhi[i][3]}
  #define PIN(x) asm volatile("":"+v"(x))
  #define MX3(a,b,c) __builtin_fmaxf(__builtin_fmaxf((a),(b)),(c))
  #define GAPA(MF,A0,A1,A2,A3,W0,W1,PW) do{ MF; sacc+=A0; sacc+=A1; sacc+=A2; sacc+=A3; PIN(sacc); W0; W1; PIN(PW); SBAR(); }while(0)
  #define EX(v) __builtin_amdgcn_exp2f(v)
  #define GAPB(MF,X,B) do{ MF; X[B]=EX(X[B]); X[B+1]=EX(X[B+1]); X[B+2]=EX(X[B+2]); X[B+3]=EX(X[B+3]); PIN(X); SBAR(); }while(0)
  #define VRD(i) do{ vlo[i]=vtr(vp_+(((i)>>2)*4096+((i)&3)*1024)); vhi[i]=vtr(vp_+(((i)>>2)*4096+((i)&3)*1024+512)); }while(0)
  #define KRD(G,j) do{ if(G){ kload2(kf,kp0+sl_next,j); SBAR(); } }while(0)
  #define STEP(C0,C1,P0,P1,t,GK,GV,GL) do{ SBAR(); \
    const lds_cptr vp_=vp0+sl_prev; \
    VRD(0); SBAR(); float sacc=(P0[0]+P0[1]); \
    GAPA(C0=__builtin_amdgcn_mfma_f32_32x32x16_bf16(kf[0],qr[0],negm,0,0,0), P0[2],P0[3],P0[4],P0[5],     pw0[0]=PKW(P0,0), pw0[1]=PKW(P0,2), pw0); \
    VRD(4); SBAR(); GAPA(C1=__builtin_amdgcn_mfma_f32_32x32x16_bf16(kf[1],qr[0],negm,0,0,0), P0[6],P0[7],P0[8],P0[9],     pw0[2]=PKW(P0,4), pw0[3]=PKW(P0,6), pw0); \
    VRD(1); SBAR(); GAPA(C0=__builtin_amdgcn_mfma_f32_32x32x16_bf16(kf[2],qr[1],C0,0,0,0),   P0[10],P0[11],P0[12],P0[13], pw1[0]=PKW(P0,8), pw1[1]=PKW(P0,10), pw1); \
    VRD(5); SBAR(); GAPA(C1=__builtin_amdgcn_mfma_f32_32x32x16_bf16(kf[3],qr[1],C1,0,0,0),   P0[14],P0[15],P1[0],P1[1],   pw1[2]=PKW(P0,12),pw1[3]=PKW(P0,14), pw1); \
    VRD(2); SBAR(); GAPA(C0=__builtin_amdgcn_mfma_f32_32x32x16_bf16(kf[4],qr[2],C0,0,0,0),   P1[2],P1[3],P1[4],P1[5],     pw2[0]=PKW(P1,0), pw2[1]=PKW(P1,2), pw2); \
    VRD(6); SBAR(); GAPA(C1=__builtin_amdgcn_mfma_f32_32x32x16_bf16(kf[5],qr[2],C1,0,0,0),   P1[6],P1[7],P1[8],P1[9],     pw2[2]=PKW(P1,4), pw2[3]=PKW(P1,6), pw2); \
    VRD(3); SBAR(); GAPA(C0=__builtin_amdgcn_mfma_f32_32x32x16_bf16(kf[6],qr[3],C0,0,0,0),   P1[10],P1[11],P1[12],P1[13], pw3[0]=PKW(P1,8), pw3[1]=PKW(P1,10), pw3); \
    VRD(7); SBAR(); GAPA(C1=__builtin_amdgcn_mfma_f32_32x32x16_bf16(kf[7],qr[3],C1,0,0,0),   P1[14],P1[15],0.f,0.f,       pw3[2]=PKW(P1,12),pw3[3]=PKW(P1,14), pw3); \
    l_reg+=sacc; \
    if(GK){DMA_K((t)+3,sl_cur);} if(GV){DMA_V((t)+1,sl_next);} \
    CMASK(C0,C1,t); \
    { float a=MX3(C0[0],C0[1],C1[0]),b=MX3(C0[2],C0[3],C1[1]); a=MX3(a,C1[2],C1[3]); \
      _Pragma("unroll") for(int r=4;r<16;r+=4){a=MX3(a,C0[r],C0[r+1]);b=MX3(b,C0[r+2],C0[r+3]);a=MX3(a,C1[r],C1[r+1]);b=MX3(b,C1[r+2],C1[r+3]);} \
      float rm=__builtin_fmaxf(a,b); { auto rr=__builtin_amdgcn_permlane32_swap(__float_as_uint(rm),__float_as_uint(rm),false,false); rm=__builtin_fmaxf(__uint_as_float(rr[0]),__uint_as_float(rr[1])); } \
      resc=false; \
      if(__builtin_expect(__any(rm>(float)THRL),0)){ const float dl=__builtin_fmaxf(rm,0.f); mhat+=dl; \
        _Pragma("unroll") for(int r=0;r<16;++r){C0[r]-=dl;C1[r]-=dl;} \
        _Pragma("unroll") for(int r=0;r<16;++r)negm[r]=-mhat; asm volatile("":"+v"(negm)); \
        const float f=__builtin_amdgcn_exp2f(-dl); l_reg*=f; if(hi==0)wsf[r32]=f; resc=true; } } \
    SBAR(); \
    GAPB(o[0]=__builtin_amdgcn_mfma_f32_32x32x16_bf16(PAF(0),VFR(0),o[0],0,0,0), C0,0); \
    GAPB(o[1]=__builtin_amdgcn_mfma_f32_32x32x16_bf16(PAF(0),VFR(4),o[1],0,0,0), C0,4); \
    KRD(GL,0); GAPB(o[0]=__builtin_amdgcn_mfma_f32_32x32x16_bf16(PAF(1),VFR(1),o[0],0,0,0), C0,8); \
    KRD(GL,1); GAPB(o[1]=__builtin_amdgcn_mfma_f32_32x32x16_bf16(PAF(1),VFR(5),o[1],0,0,0), C0,12); \
    KRD(GL,2); GAPB(o[0]=__builtin_amdgcn_mfma_f32_32x32x16_bf16(PAF(2),VFR(2),o[0],0,0,0), C1,0); \
    KRD(GL,3); GAPB(o[1]=__builtin_amdgcn_mfma_f32_32x32x16_bf16(PAF(2),VFR(6),o[1],0,0,0), C1,4); \
    GAPB(o[0]=__builtin_amdgcn_mfma_f32_32x32x16_bf16(PAF(3),VFR(3),o[0],0,0,0), C1,8); \
    GAPB(o[1]=__builtin_amdgcn_mfma_f32_32x32x16_bf16(PAF(3),VFR(7),o[1],0,0,0), C1,12); \
    }while(0)
  int t=1;
  #undef CMASK
  #define CMASK(P0,P1,t) do{ if(MODE==1){mobamask(P0,P1,sel,(t)>>2);} }while(0)
  for(;t+5<NT;t+=2){
    STEP(pB0,pB1,pA0,pA1,t,true,true,true);     WAIT_BAR(2); RESC(); ROT();
    STEP(pA0,pA1,pB0,pB1,t+1,true,true,true);   WAIT_BAR(2); RESC(); ROT();
  }
  #undef CMASK
  #define CMASK(P0,P1,t) do{int jb_=(t)-(NT-4); if(MODE==3){ if(!list&&jb_>=0)cmask(P0,P1,jb_,qrel,hi); } else if(MODE==2){swamask(P0,P1,jb_,qrel,hi);} else if(jb_>=0){cmask(P0,P1,jb_,qrel,hi);} else if(MODE==1){mobamask(P0,P1,sel,(t)>>2);} }while(0)
  #define ENDW(tt) do{ if((tt)+3<NT){WAIT_BAR(2);} else if((tt)+2<NT){WAIT_BAR(1);} else {WAIT_BAR(0);} }while(0)
  for(;t+1<NT;t+=2){
    STEP(pB0,pB1,pA0,pA1,t,(t+3<NT),(t+1<NT),(t+1<NT));       ENDW(t);   RESC(); ROT();
    STEP(pA0,pA1,pB0,pB1,t+1,(t+4<NT),(t+2<NT),(t+2<NT));     ENDW(t+1); RESC(); ROT();
  }
  STEP(pB0,pB1,pA0,pA1,NT-1,false,false,false); RESC();
  { float sacc=pB0[0]+pB0[1]; _Pragma("unroll") for(int r=2;r<16;++r)sacc+=pB0[r]; _Pragma("unroll") for(int r=0;r<16;++r)sacc+=pB1[r]; l_reg+=sacc;
    pw0=(u32x4){PKW(pB0,0),PKW(pB0,2),PKW(pB0,4),PKW(pB0,6)};pw1=(u32x4){PKW(pB0,8),PKW(pB0,10),PKW(pB0,12),PKW(pB0,14)};pw2=(u32x4){PKW(pB1,0),PKW(pB1,2),PKW(pB1,4),PKW(pB1,6)};pw3=(u32x4){PKW(pB1,8),PKW(pB1,10),PKW(pB1,12),PKW(pB1,14)};
    SBAR(); pv(o,vb0+sl_cur,PAF(0),PAF(1),PAF(2),PAF(3)); }
  #undef PKW
  #undef PAF
  #undef VFR
  #undef PIN
  #undef MX3
  #undef GAPA
  #undef GAPB
  #undef EX
  #undef VRD
  #undef KRD
  #undef STEP
  #undef ENDW
  {auto rr=__builtin_amdgcn_permlane32_swap(__float_as_uint(l_reg),__float_as_uint(l_reg),false,false);l_reg=__uint_as_float(rr[0])+__uint_as_float(rr[1]);}
  if(MODE==2)l_reg+=__builtin_amdgcn_exp2f(sinkl2-mhat);
  if(MODE==3){ const int p_=wid*QBLK+r32; if(hi==0&&p_<len)stat[p_]=mhat+__builtin_amdgcn_logf(l_reg); }
  if(hi==0)wsf[32+r32]=l_reg;asm volatile("s_waitcnt lgkmcnt(0)":::"memory");
  float rli[16];
  #pragma unroll
  for(int r=0;r<16;++r)rli[r]=__builtin_amdgcn_rcpf(wsf[32+crow(r,hi)]);
  constexpr int OP_=(MODE==3)?64:OPITCH; bf16*Ow=(MODE==3)?O+(long)(wid*QBLK)*OP_:O+(long)(q0+wid*QBLK)*OP_;
  { bf16*stg=(bf16*)(shm+LDS_OST)+wid*2048;
    #pragma unroll
    for(int r=0;r<16;++r){const int orow=crow(r,hi);
      #pragma unroll
      for(int d0=0;d0<2;++d0)stg[orow*64+d0*32+r32]=__float2bfloat16(o[d0][r]*rli[r]);}
    asm volatile("s_waitcnt lgkmcnt(0)":::"memory");
    #pragma unroll
    for(int i=0;i<4;++i){const int row=i*8+(lane>>3),ch=lane&7; const u32x4 v=*(const u32x4*)(stg+row*64+ch*8); if(MODE!=3||wid*QBLK+row<len)ATTN_STORE16(Ow+(long)row*OP_+ch*8,v);} }
  asm volatile("s_waitcnt lgkmcnt(0)\n\ts_barrier":::"memory");
  #undef DMA_K
  #undef DMA_V
  #undef CMASK
  #undef START
  #undef RESC
  #undef ROT
}

#define MG_BETTER(g,b,t,i) ((g)>(t)||((g)==(t)&&(b)<(i)))
#define MG_INS(g,b) do{ if(MG_BETTER(g,b,t3,i3)){ if(MG_BETTER(g,b,t2,i2)){ t3=t2;i3=i2; if(MG_BETTER(g,b,t1,i1)){t2=t1;i2=i1;t1=(g);i1=(b);} else {t2=(g);i2=(b);} } else {t3=(g);i3=(b);} } }while(0)
__device__ __forceinline__ void moba_gate(int qb,const bf16*Q,char*shm,const float*ksum,unsigned*cnt,int*seltmp){
  typedef __attribute__((address_space(3))) int* lds_iptr;
  int tid_=threadIdx.x; asm volatile("":"+v"(tid_)); const int tid=tid_,lane=tid&63,r32=lane&31,hi=lane>>5; const int wid=__builtin_amdgcn_readfirstlane(tid>>6);
  const int t=qb*QB+wid*QBLK+r32; const bf16*Qrow=Q+(long)t*DM; bf16x8 qr[4];
  #pragma unroll
  for(int d0=0;d0<4;++d0)qr[d0]=*reinterpret_cast<const bf16x8*>(&Qrow[d0*16+hi*8]);
  unsigned short*kt=(unsigned short*)(shm+LDS_K);
  const lds_iptr hist=(lds_iptr)((lds_cptr)shm+102400);
  #pragma unroll
  for(int i=0;i<8;++i){const int e=tid+512*i,b=e>>6,d=e&63; const float m=(ksum[e]+ksum[e+4*64*64])*(1.0f/256.0f); kt[(d>>3)*512+b*8+(d&7)]=__builtin_bit_cast(unsigned short,__float2bfloat16(m));}
  if(tid<64)hist[tid]=0;
  asm volatile("s_waitcnt vmcnt(0) lgkmcnt(0)\n\ts_barrier":::"memory");
  f32x16 g0,g1; { const f32x16 z=f32x16{}; qkt(g0,g1,shm+LDS_K,qr,z,r32,hi); }
  float t1=-INFINITY,t2=-INFINITY,t3=-INFINITY; int i1=1<<20,i2=1<<20,i3=1<<20;
  #pragma unroll
  for(int r=0;r<16;++r){ const int b=crow(r,hi); const float ga=(b<qb)?g0[r]:-INFINITY, gb=(b+32<qb)?g1[r]:-INFINITY; MG_INS(ga,b); MG_INS(gb,b+32); }
  { const float u1=__shfl_xor(t1,32),u2=__shfl_xor(t2,32),u3=__shfl_xor(t3,32); const int j1=__shfl_xor(i1,32),j2=__shfl_xor(i2,32),j3=__shfl_xor(i3,32);
    MG_INS(u1,j1); MG_INS(u2,j2); MG_INS(u3,j3); }
  if(!(t1>-INFINITY))i1=-1; if(!(t2>-INFINITY))i2=-1; if(!(t3>-INFINITY))i3=-1;
  int k1=0,k2=0,k3=0;
  if(hi==0){ if(i1>=0)k1=__hip_atomic_fetch_add(hist+i1,1,__ATOMIC_RELAXED,__HIP_MEMORY_SCOPE_WORKGROUP);
             if(i2>=0)k2=__hip_atomic_fetch_add(hist+i2,1,__ATOMIC_RELAXED,__HIP_MEMORY_SCOPE_WORKGROUP);
             if(i3>=0)k3=__hip_atomic_fetch_add(hist+i3,1,__ATOMIC_RELAXED,__HIP_MEMORY_SCOPE_WORKGROUP); }
  asm volatile("s_waitcnt vmcnt(0) lgkmcnt(0)\n\ts_barrier":::"memory");
  if(tid<64){ const int n=hist[tid]; hist[64+tid]=n>0?(int)atomicAdd(cnt+tid,(unsigned)n):0; }
  asm volatile("s_waitcnt vmcnt(0) lgkmcnt(0)\n\ts_barrier":::"memory");
  if(hi==0){ int v1=-1,v2=-1,v3=-1;
    if(i1>=0)v1=(i1<<16)|(hist[64+i1]+k1);
    if(i2>=0)v2=(i2<<16)|(hist[64+i2]+k2);
    if(i3>=0)v3=(i3<<16)|(hist[64+i3]+k3);
    seltmp[(long)t*4+0]=v1; seltmp[(long)t*4+1]=v2; seltmp[(long)t*4+2]=v3; }
  asm volatile("s_waitcnt vmcnt(0) lgkmcnt(0)\n\ts_barrier":::"memory");
}
#undef MG_INS
#undef MG_BETTER
constexpr int ATTN_LDS_BYTES=LDS_BYTES;
#undef SBAR
#undef WAIT_BAR
}

namespace cg = cooperative_groups;
constexpr int NWAVES = 8;
constexpr int M = 16384, DMODEL = 1024, DFF = 2816, QKVW = 2816, OPW = 1536;
constexpr size_t MiB = 1u << 20;
constexpr size_t WS_BAR = 512 * 1024;
constexpr size_t WS_CTL = 0;
constexpr size_t WS_SSQ = 244 * MiB;
constexpr size_t WS_KSUM = 2 * MiB;
constexpr size_t WS_COS = 3 * MiB, WS_SIN = 5 * MiB;
constexpr size_t WS_W = 8 * MiB;
constexpr size_t W_GU1 = 0, W_D1 = W_GU1 + (size_t)5632 * 1024 * 2, W_QKV = W_D1 + (size_t)1024 * 2816 * 2, W_G = W_QKV + (size_t)2816 * 1024 * 2,
                 W_BA = W_G + (size_t)3 * 1024 * 1024 * 2, W_BB = W_BA + (size_t)1024 * 256 * 2, W_BC = W_BB + (size_t)1024 * 256 * 2, W_O = W_BC + (size_t)1024 * 512 * 2,
                 W_GU2 = W_O + (size_t)1024 * 1024 * 2, W_D2 = W_GU2 + (size_t)5632 * 1024 * 2, W_END = W_D2 + (size_t)1024 * 2816 * 2;
static_assert(W_END <= 52 * MiB, "weights");
constexpr size_t WS_XB = 60 * MiB;
constexpr size_t WS_R1 = 92 * MiB;
constexpr size_t WS_OB = 180 * MiB;
constexpr size_t WS_OC = 228 * MiB;
constexpr size_t WS_OCN = WS_R1 + 64 * MiB;
constexpr size_t WS_MSTAT = 252 * MiB;
constexpr size_t WS_MSEL = 253 * MiB;
constexpr size_t WS_MLIST = 254 * MiB;
constexpr size_t WS_END = 255 * MiB;
constexpr int RING_BYTES = 131072, MISC_OFF = RING_BYTES, LDS_BYTES = 147456;
constexpr int KM_OFF = 86016;
static_assert(attn_body::ATTN_LDS_BYTES <= KM_OFF && KM_OFF + 16384 <= RING_BYTES, "lds map");

#define LAS __attribute__((address_space(3)))
typedef unsigned short bf16;
typedef unsigned v4u __attribute__((ext_vector_type(4)));
typedef float f32x4 __attribute__((ext_vector_type(4)));
#define LDS_WAIT() asm volatile("s_waitcnt lgkmcnt(0)" ::: "memory")
__device__ __forceinline__ unsigned f2bf(float f) { unsigned u = __builtin_bit_cast(unsigned, f); return (u + 0x7fffu + ((u >> 16) & 1u)) >> 16; }
__device__ __forceinline__ unsigned pk2(float lo, float hi) { return f2bf(lo) | (f2bf(hi) << 16); }
__device__ __forceinline__ float wave_sum(float v) {
#pragma unroll
    for (int o = 1; o < 64; o <<= 1) v += __shfl_xor(v, o);
    return v;
}

__device__ __forceinline__ void conv_item(const float* W, int ldw, int col0, int ncols, int K, const float* gain, int mode, int bsel, bf16* WT, LAS float* scr, int item, int lane) {
    const int nblk = ncols / 32, kb = item / nblk, nb = item % nblk, k0 = 64 * kb, n0 = col0 + 32 * nb;
    { float wv[32]; const float* wp = W + (size_t)(k0 + (lane >> 5)) * ldw + n0 + (lane & 31);
#pragma unroll
      for (int i = 0; i < 32; ++i) wv[i] = __builtin_nontemporal_load(&wp[(size_t)(2 * i) * ldw]);
      if (gain) {
#pragma unroll
          for (int i = 0; i < 32; ++i) wv[i] *= gain[k0 + 2 * i + (lane >> 5)]; }
#pragma unroll
      for (int i = 0; i < 32; ++i) scr[(2 * i + (lane >> 5)) * 33 + (lane & 31)] = wv[i]; }
    LDS_WAIT(); asm volatile("" ::: "memory");
    int pbase;
    if (mode == 0) pbase = 32 * nb; else if (mode == 1) pbase = 256 * (nb >> 3) + 128 * (nb & 1) + 32 * ((nb >> 1) & 3); else pbase = 256 * (nb >> 2) + 128 * bsel + 32 * (nb & 3);
    const int c = lane & 7;
#pragma unroll
    for (int j = 0; j < 4; ++j) { const int n = (lane >> 3) + 8 * j; const LAS float* s = scr + (8 * c) * 33 + n;
        const int prow = pbase + 16 * ((n >> 2) & 1) + 4 * (n >> 3) + (n & 3);
        v4u o; o.x = pk2(s[0 * 33], s[1 * 33]); o.y = pk2(s[2 * 33], s[3 * 33]); o.z = pk2(s[4 * 33], s[5 * 33]); o.w = pk2(s[6 * 33], s[7 * 33]);
        *(v4u*)(WT + (size_t)prow * K + k0 + 8 * c) = o; }
    LDS_WAIT(); asm volatile("" ::: "memory");
}

struct Args { const float* in[27]; float* out; unsigned char* ws; };

template <class ArgsRef> __device__ __forceinline__ void conv_layer(const ArgsRef& a, int l, unsigned char* wsb, LAS float* scr, int gw, int NGW, int lane, int mi_lo, int mi_hi) {
    bf16* WB = (bf16*)(wsb + WS_W);
#pragma nounroll
    for (int mi = mi_lo; mi < mi_hi; ++mi) {
        const float* W; int ldw, col0 = 0, ncols, K, mode = 0, bsel = 0; const float* gain = nullptr; size_t dst;
        switch (mi) {
            case 0: W = a.in[2] + (size_t)l * 1024 * 2816; ldw = 2816; ncols = 2816; K = 1024; gain = a.in[1] + l * 1024; mode = 2; bsel = 0; dst = W_GU1; break;
            case 1: W = a.in[3] + (size_t)l * 1024 * 2816; ldw = 2816; ncols = 2816; K = 1024; gain = a.in[1] + l * 1024; mode = 2; bsel = 1; dst = W_GU1; break;
            case 2: W = a.in[4] + (size_t)l * 2816 * 1024; ldw = 1024; ncols = 1024; K = 2816; dst = W_D1; break;
            case 3: W = a.in[6] + (size_t)l * 1024 * 5888; ldw = 5888; ncols = 2816; K = 1024; gain = a.in[5] + l * 1024; mode = 1; dst = W_QKV; break;
            case 4: W = a.in[6] + (size_t)l * 1024 * 5888; ldw = 5888; col0 = 2816; ncols = 1024; K = 1024; gain = a.in[5] + l * 1024; dst = W_G; break;
            case 5: W = a.in[6] + (size_t)l * 1024 * 5888; ldw = 5888; col0 = 3840; ncols = 1024; K = 1024; gain = a.in[5] + l * 1024; dst = W_G + (size_t)1024 * 1024 * 2; break;
            case 6: W = a.in[6] + (size_t)l * 1024 * 5888; ldw = 5888; col0 = 4864; ncols = 1024; K = 1024; gain = a.in[5] + l * 1024; dst = W_G + (size_t)2 * 1024 * 1024 * 2; break;
            case 7: W = a.in[19] + (size_t)l * 256 * 1024; ldw = 1024; ncols = 1024; K = 256; dst = W_BA; break;
            case 8: W = a.in[20] + (size_t)l * 256 * 1024; ldw = 1024; ncols = 1024; K = 256; dst = W_BB; break;
            case 9: W = a.in[21] + (size_t)l * 512 * 1024; ldw = 1024; ncols = 1024; K = 512; dst = W_BC; break;
            case 10: W = a.in[22] + (size_t)l * 1024 * 1024; ldw = 1024; ncols = 1024; K = 1024; dst = W_O; break;
            case 11: W = a.in[24] + (size_t)l * 1024 * 2816; ldw = 2816; ncols = 2816; K = 1024; gain = a.in[23] + l * 1024; mode = 2; bsel = 0; dst = W_GU2; break;
            case 12: W = a.in[25] + (size_t)l * 1024 * 2816; ldw = 2816; ncols = 2816; K = 1024; gain = a.in[23] + l * 1024; mode = 2; bsel = 1; dst = W_GU2; break;
            default: W = a.in[26] + (size_t)l * 2816 * 1024; ldw = 1024; ncols = 1024; K = 2816; dst = W_D2; break;
        }
        const int nitems = (K / 64) * (ncols / 32);
        bf16* WT = (bf16*)((unsigned char*)WB + dst);
        for (int it = gw; it < nitems; it += NGW) conv_item(W, ldw, col0, ncols, K, gain, mode, bsel, WT, scr, it, lane);
    }
}

constexpr int N_HEAVY = 64 * 20, N_UNITS = N_HEAVY + 256;
constexpr float LOG2E = 1.4426950408889634f;

#define XB_TMO      128
#define XB_XCNT(j)  (256  + 64 * (j))
#define XB_XSUB(j)  (1280 + 64 * (j))
#define XB_XGEN(j)  (2304 + 64 * (j))
#define XB_TOP      3328
#define XB_TOPGEN   3392
#define XCD_BAR_WORDS 3456
#define XB_SPIN_CAP (1u << 18)

__device__ __forceinline__ unsigned xb_ld(unsigned* p)              { return __hip_atomic_load(p, __ATOMIC_RELAXED, __HIP_MEMORY_SCOPE_AGENT); }
__device__ __forceinline__ unsigned xb_add(unsigned* p, unsigned v) { return __hip_atomic_fetch_add(p, v, __ATOMIC_RELAXED, __HIP_MEMORY_SCOPE_AGENT); }
__device__ __forceinline__ unsigned xb_xcc_id() { return (unsigned)__builtin_amdgcn_s_getreg((3 << 11) | 20) & 0xFu; }
#define XB_SPIN(cond, bar) do { unsigned _sp = 0; while (cond) { __builtin_amdgcn_s_sleep(1); \
    if ((++_sp & 255u) == 0u) { if (xb_ld(&(bar)[XB_TMO])) break; if (_sp > XB_SPIN_CAP) { atomicAdd(&(bar)[XB_TMO], 1u); break; } } } } while (0)

struct XcdBarrier {
    unsigned* bar; unsigned x;
    volatile LAS unsigned* st;
};

__device__ __forceinline__ XcdBarrier xcd_barrier_post(unsigned* bar, volatile LAS unsigned* st) {
    XcdBarrier b; b.bar = bar; b.x = xb_xcc_id(); b.st = st;
    if (threadIdx.x == 0) (void)xb_add(&bar[XB_XCNT(b.x)], 1u);
    return b;
}
__device__ __forceinline__ void xcd_barrier_complete(unsigned* bar, unsigned x, unsigned& nloc, unsigned& nx) {
    const unsigned G = gridDim.x * gridDim.y * gridDim.z;
    unsigned sum, cnt, mine, sp = 0u;
    for (;;) {
        sum = 0u; cnt = 0u; mine = 0u;
#pragma unroll
        for (unsigned j = 0; j < 16; ++j) { const unsigned c = xb_ld(&bar[XB_XCNT(j)]); sum += c; cnt += (c > 0u) ? 1u : 0u; mine = (j == x) ? c : mine; }
        if (sum == G) break;
        __builtin_amdgcn_s_sleep(1);
        if ((++sp & 255u) == 0u) { if (xb_ld(&bar[XB_TMO])) break; if (sp > XB_SPIN_CAP) { atomicAdd(&bar[XB_TMO], 1u); break; } }
    }
    nloc = mine > 0u ? mine : 1u; nx = cnt > 0u ? cnt : 1u;
}

__device__ __forceinline__ void xcd_barrier(const XcdBarrier& b) {
    asm volatile("s_waitcnt vmcnt(0)" ::: "memory");
    __syncthreads();
    if (threadIdx.x == 0) {
        unsigned* bar = b.bar;
        __builtin_amdgcn_s_waitcnt(0);
        unsigned nloc = b.st[0], nx = b.st[1];
        if (nloc == 0u) { xcd_barrier_complete(bar, b.x, nloc, nx); b.st[0] = nloc; b.st[1] = nx; }
        const unsigned old = xb_add(&bar[XB_XSUB(b.x)], 1u);
        const unsigned gen = old / nloc;
        if (old + 1u == (gen + 1u) * nloc) {
            __builtin_amdgcn_fence(__ATOMIC_RELEASE, "agent");
            asm volatile("s_waitcnt vmcnt(0)" ::: "memory");
            const unsigned og = xb_add(&bar[XB_TOP], 1u);
            const unsigned tg = og / nx;
            if (og + 1u == (tg + 1u) * nx) xb_add(&bar[XB_TOPGEN], 1u);
            else XB_SPIN(xb_ld(&bar[XB_TOPGEN]) == tg, bar);
            __builtin_amdgcn_fence(__ATOMIC_ACQUIRE, "agent");
            xb_add(&bar[XB_XGEN(b.x)], 1u);
            asm volatile("s_waitcnt vmcnt(0)" ::: "memory");
        } else {
            XB_SPIN(xb_ld(&bar[XB_XGEN(b.x)]) == gen, bar);
            __builtin_amdgcn_fence(__ATOMIC_ACQUIRE, "agent");
            asm volatile("s_waitcnt vmcnt(0)" ::: "memory");
        }
    }
    __syncthreads();
}

__device__ __forceinline__ int opaque_tid() { int t = threadIdx.x; asm volatile("" : "+v"(t)); return t; }
#define GRID_SYNC() do { XcdBarrier xb_; xb_.bar = (unsigned*)(ARGS().ws + WS_BAR); xb_.x = xb_xcc_id(); xb_.st = (volatile LAS unsigned*)(ldsl + MISC_OFF) + 8; xcd_barrier(xb_); } while (0)
__device__ __forceinline__ int opaque_s(int v) { asm volatile("" : "+s"(v)); return v; }
typedef const __attribute__((address_space(4))) Args* KArgsPtr;
__device__ __forceinline__ KArgsPtr opaque_kargs() { KArgsPtr p = (KArgsPtr)__builtin_amdgcn_kernarg_segment_ptr(); asm volatile("" : "+s"(p)); return p; }
#define ARGS() (*opaque_kargs())
#define WSPTR() ({ unsigned char* w_ = ARGS().ws; asm volatile("" : "+s"(w_)); w_; })
__global__ void __launch_bounds__(NWAVES * 64, 2) mega_fwd(Args args_) {
    extern __shared__ __attribute__((aligned(16))) unsigned char lds[];
    cg::grid_group grid = cg::this_grid();
    LAS unsigned char* ldsl = (LAS unsigned char*)lds;
    if (threadIdx.x == 0) { volatile LAS unsigned* mq0_ = (volatile LAS unsigned*)(ldsl + MISC_OFF); mq0_[8] = 0u; mq0_[9] = 0u; }
    __syncthreads();
    (void)xcd_barrier_post((unsigned*)(ARGS().ws + WS_BAR), (volatile LAS unsigned*)(ldsl + MISC_OFF) + 8);
    grid.sync();
    const int G0 = gridDim.x, bx0 = blockIdx.x;
#define G opaque_s(G0)
#define bx opaque_s(bx0)

    {
        unsigned char* ws = WSPTR();
        const int tid = opaque_tid(), lane = tid & 63, wave = __builtin_amdgcn_readfirstlane(tid >> 6);
        const int gw = bx * NWAVES + wave, NGW = G * NWAVES;
        unsigned* ctl = (unsigned*)(ws + WS_CTL); float* ssq = (float*)(ws + WS_SSQ);
        float* cosT = (float*)(ws + WS_COS); float* sinT = (float*)(ws + WS_SIN);
        bf16* XB = (bf16*)(ws + WS_XB);
        if (bx == 0) for (int i = tid; i < 4096; i += NWAVES * 64) ctl[i] = 0u;
        for (int i = bx * (NWAVES * 64) + tid; i < M * 32; i += G * NWAVES * 64) {
            const int pos = i >> 5, fi = i & 31;
            const float invf = exp2f(-(float)fi * (13.287712379549449f / 32.0f));
            const float ang = (float)pos * invf;
            const double rev = (double)ang * 0.15915494309189535; const double fr_ = rev - rint(rev);
            const float f = (float)fr_;
            cosT[i] = __builtin_amdgcn_cosf(f); sinT[i] = __builtin_amdgcn_sinf(f);
        }
        for (int m = gw; m < M; m += NGW) {
            const f32x4* xr = (const f32x4*)(ARGS().in[0] + (size_t)m * 1024) + lane;
            unsigned long long* o8 = (unsigned long long*)(XB + (size_t)m * 1024) + lane; float s = 0.f;
            f32x4 v[4];
#pragma unroll
            for (int j = 0; j < 4; ++j) v[j] = xr[64 * j];
#pragma unroll
            for (int j = 0; j < 4; ++j) { s += (v[j].x * v[j].x + v[j].y * v[j].y) + (v[j].z * v[j].z + v[j].w * v[j].w);
                o8[64 * j] = (unsigned long long)pk2(v[j].x, v[j].y) | ((unsigned long long)pk2(v[j].z, v[j].w) << 32); }
            s = wave_sum(s); if (lane < 4) ssq[(size_t)m * 4 + lane] = lane == 0 ? s : 0.f;
        }
        conv_layer(ARGS(), 0, ws, (LAS float*)(ldsl + wave * 16384), gw, NGW, lane, 0, 3);
    }
    GRID_SYNC();

#pragma nounroll
    for (int step = 0; step < 6; ++step) {
        if (step % 3 != 1) {
            { unsigned char* ws = WSPTR(); const int kind = step % 3;
              pg8::Gemm g{(const bf16*)(ws + WS_XB), (const bf16*)(ws + WS_W + (kind == 0 ? W_GU1 : W_GU2)), M, 5632, 1024, 1024}; pg8::StaticOrder S; S.init(M, 5632, G, bx);
              pg8::EpiFFNUp E{(bf16*)(ws + WS_R1), (const float*)(ws + WS_SSQ) + (size_t)step * M * 4};
              pg8::gemm_phase<pg8::EpiFFNUp, pg8::StaticOrder, true, true>(ldsl, g, S, E); }
            if (step != 5) {
                const int Gv = G, c = bx; const int rounds = (1408 + Gv - 1) / Gv, first_short = 1408 - (rounds - 1) * Gv;
                const bool all = first_short >= Gv;
                if (all || c >= first_short) {
                    unsigned char* ws = WSPTR(); const int tid = opaque_tid(), lane = tid & 63, wave = __builtin_amdgcn_readfirstlane(tid >> 6);
                    const int idx = all ? c : c - first_short, cnt = all ? Gv : Gv - first_short;
                    conv_layer(ARGS(), step == 0 ? 0 : 1, ws, (LAS float*)(ldsl + wave * 16384), idx * NWAVES + wave, cnt * NWAVES, lane, step == 0 ? 3 : (step == 2 ? 0 : 11), step == 0 ? 11 : (step == 2 ? 11 : 14));
                } }
            GRID_SYNC();
            { unsigned char* ws = WSPTR(); const int kind = step % 3;
              pg8::Gemm g{(const bf16*)(ws + WS_R1), (const bf16*)(ws + WS_W + (kind == 0 ? W_D1 : W_D2)), M, 1024, 2816, 2816}; pg8::StaticOrder S; S.init(M, 1024, G, bx);
              pg8::EpiResid E{step == 0 ? ARGS().in[0] : (const float*)ARGS().out, ARGS().out, (bf16*)(ws + WS_XB), (float*)(ws + WS_SSQ) + (size_t)(step + 1) * M * 4, 0.5f, step == 5 ? 1 : 0};
              pg8::gemm_phase<pg8::EpiResid, pg8::StaticOrder, false, true>(ldsl, g, S, E); }
            if (step != 5) GRID_SYNC();
        } else {
            { unsigned char* ws = WSPTR(); const int l = step / 3;
              pg8::Gemm g{(const bf16*)(ws + WS_XB), (const bf16*)(ws + WS_W + W_QKV), M, 2816, 1024, 1024}; pg8::StaticOrder S; S.init(M, 2816, G, bx);
              pg8::EpiQKV E{(bf16*)(ws + WS_R1), (const float*)(ws + WS_SSQ) + (size_t)step * M * 4, (const float*)(ws + WS_COS), (const float*)(ws + WS_SIN),
                            ARGS().in[7] + l * 64, ARGS().in[8] + l * 64, ARGS().in[9] + l * 64, ARGS().in[10] + l * 64, ARGS().in[12] + l * 64, ARGS().in[13] + l * 64, (float*)(ws + WS_KSUM), attn_body::C2};
              pg8::gemm_phase<pg8::EpiQKV, pg8::StaticOrder, true, true>(ldsl, g, S, E); }
            if (step == 1) {
                const int Gv = G, c = bx; const int rounds = (704 + Gv - 1) / Gv, first_short = 704 - (rounds - 1) * Gv; const bool all = first_short >= Gv;
                if (all || c >= first_short) {
                    unsigned char* ws = WSPTR(); const int tid = opaque_tid(), lane = tid & 63, wave = __builtin_amdgcn_readfirstlane(tid >> 6);
                    const int idx = all ? c : c - first_short, cnt = all ? Gv : Gv - first_short;
                    conv_layer(ARGS(), 0, ws, (LAS float*)(ldsl + wave * 16384), idx * NWAVES + wave, cnt * NWAVES, lane, 11, 14);
                } }
            GRID_SYNC();
            { unsigned char* ws = WSPTR(); const int l = step / 3;
              const attn_body::bf16* QKV = (const attn_body::bf16*)(ws + WS_R1);
              for (int u = bx; u < 256; u += G) { const int h = u >> 6, qb = u & 63;
                  attn_body::moba_gate(qb, QKV + 64 * h, (char*)lds, (const float*)(ws + WS_KSUM) + (size_t)h * 64 * 64, (unsigned*)(ws + WS_CTL) + 3072 + 256 * l + 64 * h, (int*)(ws + WS_MSEL) + (size_t)h * 16384 * 4); } }
            GRID_SYNC();
            { unsigned char* ws = WSPTR(); const int l = step / 3; const int tid = opaque_tid();
              volatile LAS int* T = (volatile LAS int*)(ldsl + MISC_OFF + 1024);
              const unsigned* cnt = (const unsigned*)(ws + WS_CTL) + 3072 + 256 * l;
              if (tid < 256) T[512 + tid] = 256 + (int)__hip_atomic_load(cnt + tid, __ATOMIC_RELAXED, __HIP_MEMORY_SCOPE_AGENT);
              __syncthreads();
              if (tid < 256) { const int len = T[512 + tid], cc = (len + 255) >> 8; int o = len, c = cc;
#pragma unroll
                  for (int d = 1; d < 64; d <<= 1) { const int o2 = __shfl_up(o, d), c2 = __shfl_up(c, d); if ((tid & 63) >= d) { o += o2; c += c2; } }
                  T[tid] = o - len; T[256 + tid] = c - cc; if ((tid & 63) == 63) T[768 + (tid >> 6)] = c; }
              __syncthreads();
              if (tid < 256) { const int h = tid >> 6; const int add = (h > 0 ? T[768] : 0) + (h > 1 ? T[769] : 0) + (h > 2 ? T[770] : 0); T[256 + tid] += add; }
              if (tid == 0) T[772] = T[768] + T[769] + T[770] + T[771];
              __syncthreads();
              int* SEL = (int*)(ws + WS_MSEL); unsigned short* LIST = (unsigned short*)(ws + WS_MLIST);
              for (int e = bx * (NWAVES * 64) + tid; e < 4 * 16384; e += G * NWAVES * 64) { const int h = e >> 14, t = e & 16383;
                  int v0 = SEL[(size_t)e * 4 + 0], v1 = SEL[(size_t)e * 4 + 1], v2 = SEL[(size_t)e * 4 + 2];
                  if (v0 >= 0) { const int r = T[h * 64 + (v0 >> 16)] + 256 + (v0 & 0xffff); LIST[(size_t)h * 65536 + r] = (unsigned short)t; v0 = r; }
                  if (v1 >= 0) { const int r = T[h * 64 + (v1 >> 16)] + 256 + (v1 & 0xffff); LIST[(size_t)h * 65536 + r] = (unsigned short)t; v1 = r; }
                  if (v2 >= 0) { const int r = T[h * 64 + (v2 >> 16)] + 256 + (v2 & 0xffff); LIST[(size_t)h * 65536 + r] = (unsigned short)t; v2 = r; }
                  SEL[(size_t)e * 4 + 0] = v0; SEL[(size_t)e * 4 + 1] = v1; SEL[(size_t)e * 4 + 2] = v2; SEL[(size_t)e * 4 + 3] = T[h * 64 + (t >> 8)] + (t & 255); } }
            GRID_SYNC();
            { unsigned char* ws = WSPTR(); const int l = step / 3; const int tid = opaque_tid();
              volatile LAS unsigned* MISC = (volatile LAS unsigned*)(ldsl + MISC_OFF);
              volatile LAS int* T = (volatile LAS int*)(ldsl + MISC_OFF + 1024);
              unsigned* qctr = (unsigned*)(ws + WS_CTL) + 64 * (1 + l);
              const attn_body::bf16* QKV = (const attn_body::bf16*)(ws + WS_R1); attn_body::bf16* OBa = (attn_body::bf16*)(ws + WS_OB);
              const int TC = T[772];
              for (;;) {
                  if (tid == 0) MISC[0] = atomicAdd(qctr, 1u);
                  __syncthreads(); const int u = __builtin_amdgcn_readfirstlane((int)MISC[0]); __syncthreads();
                  if (u >= 1024 + TC + 256) break;
                  if (u < 1024) { const int qb = 63 - u / 16, hv = u % 16; const int h = hv >> 2, sub = hv & 3;
                      attn_body::attn_unit<0, 8>(qb, 0, QKV + 1280 + 128 * h + 64 * (sub >> 1), QKV + 1792 + 128 * h + 64 * (sub >> 1), QKV + 2304 + 128 * h + 64 * (sub & 1),
                                                 OBa + 512 + 256 * h + 128 * (sub >> 1) + 64 * (sub & 1), (char*)lds, nullptr, 0.f);
                  } else if (u < 1024 + TC) { const int j = u - 1024; int lo = 0, hi = 255;
                      while (lo < hi) { const int mid = (lo + hi + 1) >> 1; if (T[256 + mid] <= j) lo = mid; else hi = mid - 1; }
                      const int i = __builtin_amdgcn_readfirstlane(lo), h = i >> 6, b = i & 63, c = j - T[256 + i], rb = T[i] + 256 * c; const int n = T[512 + i] - 256 * c;
                      attn_body::bf16* PART = (h < 2 ? (attn_body::bf16*)(ws + WS_W + W_GU1) + (size_t)h * 65536 * 64 : (attn_body::bf16*)(ws + WS_OC) + (size_t)(h - 2) * 65536 * 64) + (size_t)rb * 64;
                      attn_body::attn_unit<3, 0>(b, 4 * b, QKV + 64 * h, QKV + 256 + 64 * h, QKV + 512 + 64 * h, PART, (char*)lds, nullptr, 0.f,
                                                 c == 0 ? nullptr : (const unsigned short*)(ws + WS_MLIST) + (size_t)h * 65536 + rb, n < 256 ? n : 256, (float*)(ws + WS_MSTAT) + (size_t)h * 65536 + rb);
                  } else { const int s = u - 1024 - TC, hq = s & 3, qb = s >> 2; const int t0 = qb == 0 ? 0 : 4 * qb - 2;
                      attn_body::attn_unit<2, 8>(qb, t0, QKV + 768 + 64 * hq, QKV + 1024 + 64 * (hq >> 1), QKV + 1152 + 64 * (hq >> 1), OBa + 256 + 64 * hq, (char*)lds, nullptr, ARGS().in[11][l * 4 + hq] * LOG2E); }
              } }
            GRID_SYNC();
            { unsigned char* ws = WSPTR(); const int tid = opaque_tid(), lane = tid & 63, wave = __builtin_amdgcn_readfirstlane(tid >> 6);
              const int gw = bx * NWAVES + wave, NGW = G * NWAVES; const int h = lane >> 4, j4 = (lane & 15) * 4;
              const bf16* PART = h < 2 ? (const bf16*)(ws + WS_W + W_GU1) + (size_t)h * 65536 * 64 : (const bf16*)(ws + WS_OC) + (size_t)(h - 2) * 65536 * 64;
              const float* ST = (const float*)(ws + WS_MSTAT) + (size_t)h * 65536; const int* SEL = (const int*)(ws + WS_MSEL) + (size_t)h * 16384 * 4; bf16* OB = (bf16*)(ws + WS_OB);
              for (int t0 = gw; t0 < 16384; t0 += 4 * NGW) {
                  typedef int i32x4 __attribute__((ext_vector_type(4)));
                  i32x4 rr[4]; float wl[4][4]; unsigned long long qv[4][4];
#pragma unroll
                  for (int k = 0; k < 4; ++k) rr[k] = *(const i32x4*)(SEL + (size_t)(t0 + k * NGW) * 4);
#pragma unroll
                  for (int k = 0; k < 4; ++k)
#pragma unroll
                      for (int q = 0; q < 4; ++q) { const int r = rr[k][q]; const int rc = r >= 0 ? r : 0; const float w = ST[rc]; wl[k][q] = r >= 0 ? w : -INFINITY; qv[k][q] = *(const unsigned long long*)(PART + (size_t)rc * 64 + j4); }
#pragma unroll
                  for (int k = 0; k < 4; ++k) { const int t = t0 + k * NGW;
                      const float mx = fmaxf(fmaxf(wl[k][0], wl[k][1]), fmaxf(wl[k][2], wl[k][3]));
                      float a0 = 0.f, a1 = 0.f, a2 = 0.f, a3 = 0.f, ws_ = 0.f;
#pragma unroll
                      for (int q = 0; q < 4; ++q) { const float w = __builtin_amdgcn_exp2f(wl[k][q] - mx); ws_ += w; const unsigned lo_ = (unsigned)qv[k][q], hi_ = (unsigned)(qv[k][q] >> 32);
                          a0 += w * __uint_as_float(lo_ << 16); a1 += w * __uint_as_float(lo_ & 0xffff0000u); a2 += w * __uint_as_float(hi_ << 16); a3 += w * __uint_as_float(hi_ & 0xffff0000u); }
                      const float inv = 1.0f / ws_;
                      *(unsigned long long*)(OB + (size_t)t * OPW + 64 * h + j4) = (unsigned long long)pk2(a0 * inv, a1 * inv) | ((unsigned long long)pk2(a2 * inv, a3 * inv) << 32); }
              } }
            { unsigned char* ws = WSPTR(); const int l = step / 3;
              const int tid = opaque_tid(), lane = tid & 63, wave = __builtin_amdgcn_readfirstlane(tid >> 6);
              const int gw = bx * NWAVES + wave, NGW = G * NWAVES;
              const bf16* OB = (const bf16*)(ws + WS_OB); bf16* OC = (bf16*)(ws + WS_OCN);
              const float lam_init = l == 0 ? 0.2f : 0.35550907f;
              const float s1 = wave_sum(ARGS().in[14][l * 64 + lane] * ARGS().in[15][l * 64 + lane]), s2 = wave_sum(ARGS().in[16][l * 64 + lane] * ARGS().in[17][l * 64 + lane]);
              const float lam = expf(s1) - expf(s2) + lam_init;
              const int h = lane >> 4, c0 = (lane & 15) * 8;
              f32x4 sg0 = *(const f32x4*)(ARGS().in[18] + l * 128 + c0), sg1 = *(const f32x4*)(ARGS().in[18] + l * 128 + c0 + 4);
              sg0 = sg0 * (1.0f - lam_init); sg1 = sg1 * (1.0f - lam_init);
              for (int m = gw; m < M; m += NGW) {
                  const bf16* op = OB + (size_t)m * OPW + 512 + 256 * h + c0;
                  f32x4 a0, a1, b0, b1; pg8::unpack8(*(const v4u*)op, a0, a1); pg8::unpack8(*(const v4u*)(op + 128), b0, b1);
                  a0 = a0 - b0 * lam; a1 = a1 - b1 * lam;
                  float ss = (a0[0] * a0[0] + a0[1] * a0[1]) + (a0[2] * a0[2] + a0[3] * a0[3]) + (a1[0] * a1[0] + a1[1] * a1[1]) + (a1[2] * a1[2] + a1[3] * a1[3]);
                  ss += __shfl_xor(ss, 1); ss += __shfl_xor(ss, 2); ss += __shfl_xor(ss, 4); ss += __shfl_xor(ss, 8);
                  const float rn = __builtin_amdgcn_rsqf(ss * (1.0f / 128.0f) + 1e-6f);
                  *(v4u*)(OC + (size_t)m * 512 + 128 * h + c0) = pg8::pack8(a0 * rn * sg0, a1 * rn * sg1);
              } }
            GRID_SYNC();
#define BRANCH_PAIR(WG_OFF, A_EXPR, KB, LDA, WB_OFF, FIRST) \
            { unsigned char* ws = WSPTR(); \
              pg8::Gemm g{(const bf16*)(ws + WS_XB), (const bf16*)(ws + WS_W + W_G + (WG_OFF)), M, 1024, 1024, 1024}; pg8::StaticOrder S; S.init(M, 1024, G, bx); \
              pg8::EpiGate E{(bf16*)(ws + WS_R1), (const float*)(ws + WS_SSQ) + (size_t)step * M * 4}; \
              pg8::gemm_phase<pg8::EpiGate, pg8::StaticOrder, true, true>(ldsl, g, S, E); } \
            { unsigned char* ws = WSPTR(); \
              pg8::Gemm g{(const bf16*)(A_EXPR), (const bf16*)(ws + WS_W + (WB_OFF)), M, 1024, (KB), (LDA)}; pg8::StaticOrder S; S.init(M, 1024, G, bx); \
              pg8::EpiBranch E{(const bf16*)(ws + WS_R1), (bf16*)(ws + WS_R1 + 32 * MiB), (FIRST)}; \
              pg8::gemm_phase<pg8::EpiBranch, pg8::StaticOrder, true, true>(ldsl, g, S, E); }
            BRANCH_PAIR((size_t)0, ws + WS_OB, 256, OPW, W_BA, 1)
            BRANCH_PAIR((size_t)1024 * 1024 * 2, ws + WS_OB + 512, 256, OPW, W_BB, 0)
            BRANCH_PAIR((size_t)2 * 1024 * 1024 * 2, ws + WS_OCN, 512, 512, W_BC, 0)
#undef BRANCH_PAIR
            GRID_SYNC();
            { unsigned char* ws = WSPTR();
              pg8::Gemm g{(const bf16*)(ws + WS_R1 + 32 * MiB), (const bf16*)(ws + WS_W + W_O), M, 1024, 1024, 1024}; pg8::StaticOrder S; S.init(M, 1024, G, bx);
              pg8::EpiResid E{(const float*)ARGS().out, ARGS().out, (bf16*)(ws + WS_XB), (float*)(ws + WS_SSQ) + (size_t)(step + 1) * M * 4, 1.0f, 0};
              pg8::gemm_phase<pg8::EpiResid, pg8::StaticOrder, false, true>(ldsl, g, S, E); }
            GRID_SYNC();
        }
    }
}

#undef G
#undef bx
extern "C" void kernel_launch(void* const* d_in, const int* in_sizes, int n_in, void* d_out, int out_size, void* d_ws, size_t ws_size, hipStream_t stream) {
    static int grid = 0;
    if (grid == 0) {
        if (n_in != 27 || out_size != M * DMODEL || ws_size < WS_END) { fprintf(stderr, "kernel_launch: unexpected shapes (n_in %d out %d ws %zu)\n", n_in, out_size, ws_size); grid = -1; return; }
        int dev = 0, cus = 0, per_cu = 0;
        hipGetDevice(&dev); hipDeviceGetAttribute(&cus, hipDeviceAttributeMultiprocessorCount, dev);
        hipFuncSetAttribute((const void*)mega_fwd, hipFuncAttributeMaxDynamicSharedMemorySize, LDS_BYTES);
        hipOccupancyMaxActiveBlocksPerMultiprocessor(&per_cu, (const void*)mega_fwd, NWAVES * 64, LDS_BYTES);
        if (per_cu < 1) { fprintf(stderr, "kernel_launch: occupancy query says %d blocks per CU\n", per_cu); per_cu = 1; }
        (void)hipGetLastError();
        grid = cus;
    }
    if (grid < 0) return;
    (void)hipMemsetAsync((char*)d_ws + WS_BAR, 0, 16384, stream);
    Args a{};
    for (int i = 0; i < 27; ++i) a.in[i] = (const float*)d_in[i];
    a.out = (float*)d_out; a.ws = (unsigned char*)d_ws;
    void* kargs[] = {&a};
    hipError_t e = hipLaunchCooperativeKernel((const void*)mega_fwd, dim3(grid), dim3(NWAVES * 64), kargs, LDS_BYTES, stream);
    if (e != hipSuccess) fprintf(stderr, "cooperative launch failed: %s (grid %d)\n", hipGetErrorString(e), grid);
}
```
